# Optimizing an MI355X kernel written in HIP

```python
import math
import jax, jax.numpy as jnp
from jax import lax
import numpy as np

D_MODEL = 2048
BATCH = 2
SEQ = 16384
DEPTH = 1

DA_HEADS = 8
DA_HEAD_DIM = 64
DA_V_DIM = 2 * DA_HEAD_DIM
DA_QK_WIDTH = DA_HEADS * 2 * DA_HEAD_DIM
DA_WIDTH = DA_HEADS * DA_V_DIM
ROPE_THETA = 500000.0
ROPE_DIM = DA_HEAD_DIM // 4
Q_BLOCK = 128
GLA_HEADS = 4
GLA_KEY_DIM = 128
GLA_VAL_DIM = 256
GLA_QK_WIDTH = GLA_HEADS * GLA_KEY_DIM
GLA_WIDTH = GLA_HEADS * GLA_VAL_DIM
GLA_GATE_RANK = 16
GLA_GATE_TAU = 16.0
GLA_CHUNK = 64
D_FF = 4 * D_MODEL
N_MOD = 6
EPS = 1e-6

IN_SIZES = (DA_QK_WIDTH, DA_QK_WIDTH, DA_WIDTH,
            GLA_QK_WIDTH, GLA_QK_WIDTH, GLA_WIDTH, GLA_WIDTH, GLA_GATE_RANK,
            D_MODEL, D_MODEL)
IN_WIDTH = (3 * DA_QK_WIDTH + 2 * GLA_QK_WIDTH + 2 * GLA_WIDTH + GLA_GATE_RANK + 2 * D_MODEL)

kernel_name = "hybrid_diffattn_gla_gated_block"


def _split_points():
    pts, acc = [], 0
    for s in IN_SIZES[:-1]:
        acc += s
        pts.append(acc)
    return pts


def rms_norm(x, g):
    xf = x.astype(jnp.float32)
    y = xf * lax.rsqrt(jnp.mean(xf * xf, axis=-1, keepdims=True) + EPS)
    return (y * g.astype(jnp.float32)).astype(x.dtype)


def partial_rope(t, cos, sin):
    half = ROPE_DIM // 2
    tr, tp = t[..., :ROPE_DIM], t[..., ROPE_DIM:]
    rot = jnp.concatenate([-tr[..., half:], tr[..., :half]], axis=-1)
    return jnp.concatenate([tr * cos + rot * sin, tp], axis=-1)


def diff_attention(q, k, v, positions, q_norm_g, k_norm_g, lq1, lk1, lq2, lk2, subln_g, layer_idx):
    B, S = q.shape[0], q.shape[1]
    f32 = jnp.float32
    q = rms_norm(q.reshape(B, S, DA_HEADS, 2, DA_HEAD_DIM).astype(f32), q_norm_g)
    k = rms_norm(k.reshape(B, S, DA_HEADS, 2, DA_HEAD_DIM).astype(f32), k_norm_g)
    vf = v.reshape(B, S, DA_HEADS, DA_V_DIM).astype(f32)
    inv_freq = ROPE_THETA ** (-jnp.arange(0, ROPE_DIM, 2, dtype=f32) / ROPE_DIM)
    ang = positions.astype(f32)[..., None] * inv_freq
    ang = jnp.concatenate([ang, ang], axis=-1)[:, :, None, None, :]
    cos, sin = jnp.cos(ang), jnp.sin(ang)
    q = partial_rope(q, cos, sin) * (DA_HEAD_DIM ** -0.5)
    k = partial_rope(k, cos, sin)
    lam_init = 0.8 - 0.6 * math.exp(-0.3 * layer_idx)
    lam = (jnp.exp(jnp.sum(lq1.astype(f32) * lk1.astype(f32)))
           - jnp.exp(jnp.sum(lq2.astype(f32) * lk2.astype(f32))) + lam_init)
    nb = S // Q_BLOCK
    q_blocks = q.reshape(B, nb, Q_BLOCK, DA_HEADS, 2, DA_HEAD_DIM).transpose(1, 0, 2, 3, 4, 5)
    key_idx = jnp.arange(S)

    def one_block(args):
        qb, bi = args
        s = jnp.einsum('bqhcd,bkhcd->bhcqk', qb, k)
        q_idx = bi * Q_BLOCK + jnp.arange(Q_BLOCK)
        mask = key_idx[None, :] <= q_idx[:, None]
        p = jax.nn.softmax(jnp.where(mask, s, -jnp.inf), axis=-1)
        w = p[:, :, 0] - lam * p[:, :, 1]
        return jnp.einsum('bhqk,bkhe->bqhe', w, vf)

    o = lax.map(one_block, (q_blocks, jnp.arange(nb)))
    o = o.transpose(1, 0, 2, 3, 4).reshape(B, S, DA_HEADS, DA_V_DIM)
    o = rms_norm(o, subln_g) * (1.0 - lam_init)
    return o.reshape(B, S, DA_WIDTH)


def gated_linear_attention(q, k, v, r, a_low, a_up, a_bias, out_norm_g):
    B, S = q.shape[0], q.shape[1]
    f32 = jnp.float32
    C = GLA_CHUNK
    nc = S // C
    q = q.reshape(B, S, GLA_HEADS, GLA_KEY_DIM).astype(f32) * (GLA_KEY_DIM ** -0.5)
    k = k.reshape(B, S, GLA_HEADS, GLA_KEY_DIM).astype(f32)
    v = v.reshape(B, S, GLA_HEADS, GLA_VAL_DIM).astype(f32)
    log_a = jax.nn.log_sigmoid((a_low @ a_up + a_bias).astype(f32)) / GLA_GATE_TAU
    log_a = log_a.reshape(B, S, GLA_HEADS, GLA_KEY_DIM)

    def to_chunks(t):
        return t.reshape(B, nc, C, *t.shape[2:]).swapaxes(0, 1)

    causal = jnp.tril(jnp.ones((C, C), dtype=bool))

    def step(state, inp):
        qc, kc, vc, lac = inp
        b = jnp.cumsum(lac, axis=1)
        o_inter = jnp.einsum('bihk,bhkv->bihv', qc * jnp.exp(b), state)
        rel = b[:, :, None] - b[:, None]
        decay = jnp.exp(jnp.where(causal[None, :, :, None, None], rel, -jnp.inf))
        att = jnp.einsum('bihk,bjhk,bijhk->bhij', qc, kc, decay)
        o_intra = jnp.einsum('bhij,bjhv->bihv', att, vc)
        b_last = b[:, -1]
        state = (jnp.exp(b_last)[..., None] * state
                 + jnp.einsum('bjhk,bjhv->bhkv', kc * jnp.exp(b_last[:, None] - b), vc))
        return state, o_inter + o_intra

    state0 = jnp.zeros((B, GLA_HEADS, GLA_KEY_DIM, GLA_VAL_DIM), f32)
    _, o = lax.scan(step, state0, (to_chunks(q), to_chunks(k), to_chunks(v), to_chunks(log_a)))
    o = o.swapaxes(0, 1).reshape(B, S, GLA_HEADS, GLA_VAL_DIM)
    o = rms_norm(o, out_norm_g) * jax.nn.silu(r.astype(f32)).reshape(B, S, GLA_HEADS, GLA_VAL_DIM)
    return o.reshape(B, S, GLA_WIDTH)


def setup_inputs(seed: int = 0) -> dict:
    key = jax.random.key(seed)
    ks = jax.random.split(key, 24)
    f32 = jnp.float32
    L, D = DEPTH, D_MODEL

    def nrm(k, shape, scale):
        return jax.random.normal(k, shape, f32) * scale

    def gain(k, shape):
        return 1.0 + 0.02 * jax.random.normal(k, shape, f32)

    x = jax.random.normal(ks[0], (BATCH, SEQ, D), f32)
    c = jax.random.normal(ks[1], (BATCH, D), f32)
    positions = (jnp.arange(SEQ, dtype=jnp.int32)[None, :]
                 + jax.random.randint(ks[2], (BATCH, 1), 0, 1024, dtype=jnp.int32))
    return {
        "x": x,
        "c": c,
        "positions": positions,
        "w_ada": nrm(ks[3], (L, D, N_MOD * D), 0.5 * D ** -0.5),
        "b_ada": nrm(ks[4], (L, N_MOD * D), 0.02),
        "norm1_g": gain(ks[5], (L, D)),
        "w_in": nrm(ks[6], (L, D, IN_WIDTH), D ** -0.5),
        "da_q_norm_g": gain(ks[7], (L, DA_HEAD_DIM)),
        "da_k_norm_g": gain(ks[8], (L, DA_HEAD_DIM)),
        "da_lambda_q1": nrm(ks[9], (L, DA_HEAD_DIM), 0.1),
        "da_lambda_k1": nrm(ks[10], (L, DA_HEAD_DIM), 0.1),
        "da_lambda_q2": nrm(ks[11], (L, DA_HEAD_DIM), 0.1),
        "da_lambda_k2": nrm(ks[12], (L, DA_HEAD_DIM), 0.1),
        "da_subln_g": gain(ks[13], (L, DA_V_DIM)),
        "gla_gate_up": nrm(ks[14], (L, GLA_GATE_RANK, GLA_QK_WIDTH), GLA_GATE_RANK ** -0.5),
        "gla_gate_bias": nrm(ks[15], (L, GLA_QK_WIDTH), 0.1),
        "gla_out_norm_g": gain(ks[16], (L, GLA_VAL_DIM)),
        "w_branch_a": nrm(ks[17], (L, DA_WIDTH, D), DA_WIDTH ** -0.5),
        "w_branch_b": nrm(ks[18], (L, GLA_WIDTH, D), GLA_WIDTH ** -0.5),
        "w_out": nrm(ks[19], (L, D, D), D ** -0.5),
        "norm2_g": gain(ks[20], (L, D)),
        "w_mlp_in": nrm(ks[21], (L, D, D_FF), D ** -0.5),
        "w_mlp_out": nrm(ks[22], (L, D_FF, D), D_FF ** -0.5),
    }


def reference(x, c, positions, w_ada, b_ada, norm1_g, w_in, da_q_norm_g, da_k_norm_g,
              da_lambda_q1, da_lambda_k1, da_lambda_q2, da_lambda_k2, da_subln_g,
              gla_gate_up, gla_gate_bias, gla_out_norm_g, w_branch_a, w_branch_b, w_out,
              norm2_g, w_mlp_in, w_mlp_out):
    h = x
    split_pts = _split_points()
    for l in range(DEPTH):
        mod = jax.nn.silu(c) @ w_ada[l] + b_ada[l]
        shift1, scale1, gate1, shift2, scale2, gate2 = jnp.split(mod[:, None, :], N_MOD, axis=-1)
        u = rms_norm(h, norm1_g[l]) * (1.0 + scale1) + shift1
        proj = u @ w_in[l]
        (da_q, da_k, da_v, g_q, g_k, g_v, g_r, g_a, gate_a, gate_b) = jnp.split(proj, split_pts, axis=-1)
        y_a = diff_attention(da_q, da_k, da_v, positions, da_q_norm_g[l], da_k_norm_g[l],
                             da_lambda_q1[l], da_lambda_k1[l], da_lambda_q2[l], da_lambda_k2[l],
                             da_subln_g[l], l).astype(h.dtype)
        y_b = gated_linear_attention(g_q, g_k, g_v, g_r, g_a, gla_gate_up[l], gla_gate_bias[l],
                                     gla_out_norm_g[l]).astype(h.dtype)
        merged = (jax.nn.sigmoid(gate_a) * (y_a @ w_branch_a[l])
                  + jax.nn.sigmoid(gate_b) * (y_b @ w_branch_b[l]))
        h = h + gate1 * (merged @ w_out[l])
        u2 = rms_norm(h, norm2_g[l]) * (1.0 + scale2) + shift2
        hid = jnp.square(jax.nn.relu(u2 @ w_mlp_in[l]))
        h = h + gate2 * (hid @ w_mlp_out[l])
    return h
```

```cpp
#include <hip/hip_runtime.h>
#include <hip/hip_cooperative_groups.h>
#include <cstdio>
#include <cstdint>
namespace cg = cooperative_groups;
#ifndef PH_MASK
#define PH_MASK 0x7ff
#endif
namespace pg8 {
#define PG8_LAS __attribute__((address_space(3)))
typedef unsigned short bf16_t;
typedef short bf16x8 __attribute__((ext_vector_type(8)));
typedef float f32x4 __attribute__((ext_vector_type(4)));
typedef unsigned u32x4 __attribute__((ext_vector_type(4)));
constexpr int BM = 256, BK = 64, HALF = 128, HTB = HALF * BK * 2  , STAGE_BYTES = 8 * HTB, NXCD = 8, WGM = 8;

__host__ __device__ __forceinline__ int lds_byte(int r, int c) { const int st = (r >> 4) * 2 + (c >> 5), rr = r & 15, cc = c & 31, ob = rr * 64 + cc * 2; return st * 1024 + (ob ^ (((ob >> 9) & 1) << 5)); }
__host__ __device__ __forceinline__ void stage_rc(int b, int& R, int& C) { const int st = b / 1024, sb = b % 1024, swz = sb ^ (((sb >> 9) & 1) << 5); R = (st >> 1) * 16 + swz / 64; C = (st & 1) * 32 + (swz % 64) / 2; }
__host__ __device__ __forceinline__ int perm32(int rho) { const int n = rho >> 4, i = rho & 15; return 8 * (i >> 2) + 4 * n + (i & 3); }

struct Unit { int pm, pn; };
struct Gemm { const bf16_t* A; const bf16_t* Bt; int M, N, K; };

struct StaticOrder {
    int nM, nN, nwg, G, c;
    __host__ __device__ void init(int M, int N, int G_, int c_) { nM = M / BM; nN = N / BM; nwg = nM * nN; G = G_; c = c_; }
    __host__ __device__ bool next(int i, Unit& u) const {
        const long L = (long)i * G + c; if (L >= nwg) return false;
        int wgid = (int)L; { const int q = nwg / NXCD, r = nwg % NXCD, xcd = wgid % NXCD, off = wgid / NXCD; wgid = (xcd < r ? xcd * (q + 1) : r * (q + 1) + (xcd - r) * q) + off; }
        const int nig = WGM * nN, gid = wgid / nig, fm = gid * WGM, gsz = (nM - fm) < WGM ? (nM - fm) : WGM;
        u.pm = fm + ((wgid % nig) % gsz); u.pn = (wgid % nig) / gsz; return true;
    }
    __device__ __forceinline__ void a_ready(const Unit&) const {}
    __device__ __forceinline__ void done(const Unit&) const {}
};

__device__ __forceinline__ unsigned cvt_pk_bf16(float lo, float hi) { unsigned r; asm volatile("v_cvt_pk_bf16_f32 %0, %1, %2" : "=v"(r) : "v"(lo), "v"(hi)); return r; }
typedef float f32x2 __attribute__((ext_vector_type(2)));
__device__ __forceinline__ f32x2 gelu_pk(f32x2 v) {
    const f32x2 av = __builtin_elementwise_abs(v), d = av * 0.2316418882f + 1.0f;
    f32x2 t; t.x = __builtin_amdgcn_rcpf(d.x); t.y = __builtin_amdgcn_rcpf(d.y);
    f32x2 q = t * 0.5307027145f + (-0.7265760135f); q = q * t + 0.7107068705f; q = q * t + (-0.142248368f); q = q * t + 0.127414796f; q = q * t;
    const f32x2 s = (v * v) * (-0.72134752044f);
    f32x2 e; e.x = __builtin_amdgcn_exp2f(s.x); e.y = __builtin_amdgcn_exp2f(s.y);
    const f32x2 m = v * (q * e), r = v - m;
    f32x2 o; o.x = v.x < 0.f ? m.x : r.x; o.y = v.y < 0.f ? m.y : r.y; return o;
}

template <int ACT  > struct EpiBf16 {
    static constexpr bool PERM = true, AFTER_DRAIN = false; static_assert(ACT == 0 || ACT == 1, "EpiBf16: ACT is 0 (none) or 1 (gelu_pk)");
    bf16_t* O; int ldc; const float* bias; int split_cols; size_t split_stride; float scale0;
    __device__ __forceinline__ void operator()(const f32x4 (&acc)[2][2][4][2], const Unit& u, int wr, int wc, int fr, int fq) const {
        const int row0 = u.pm * BM + wr * 64 + fr; int colt = u.pn * BM; bf16_t* base = O;
        float sc = 1.f; if (split_cols) { const int t = colt / split_cols; base += (size_t)t * split_stride; colt -= t * split_cols; if (t == 0) sc = scale0; }
        const int col0 = colt + wc * 32 + 8 * fq, bcol0 = u.pn * BM + wc * 32 + 8 * fq;
        f32x4 bv[2][2];
#pragma unroll
        for (int bj = 0; bj < 2; ++bj)
#pragma unroll
            for (int n = 0; n < 2; ++n) bv[bj][n] = bias ? *(const f32x4*)(bias + bcol0 + bj * HALF + 4 * n) : (f32x4){0.f, 0.f, 0.f, 0.f};
#pragma unroll
        for (int ai = 0; ai < 2; ++ai)
#pragma unroll
            for (int m = 0; m < 4; ++m) { bf16_t* rowp = base + (size_t)(row0 + ai * HALF + m * 16) * ldc + col0;
#pragma unroll
                for (int bj = 0; bj < 2; ++bj) { f32x4 v0 = acc[ai][bj][m][0] + bv[bj][0], v1 = acc[ai][bj][m][1] + bv[bj][1];
                    if (ACT == 1) { f32x2 a = gelu_pk((f32x2){v0[0], v0[1]}), b = gelu_pk((f32x2){v0[2], v0[3]}), c = gelu_pk((f32x2){v1[0], v1[1]}), d = gelu_pk((f32x2){v1[2], v1[3]});
                        v0 = (f32x4){a.x, a.y, b.x, b.y}; v1 = (f32x4){c.x, c.y, d.x, d.y}; }
                    v0 = v0 * sc; v1 = v1 * sc; u32x4 w; w.x = cvt_pk_bf16(v0[0], v0[1]); w.y = cvt_pk_bf16(v0[2], v0[3]); w.z = cvt_pk_bf16(v1[0], v1[1]); w.w = cvt_pk_bf16(v1[2], v1[3]);
                    *(u32x4*)(rowp + bj * HALF) = w; } }
    }
};
__device__ __forceinline__ float fsigmoid(float x) { return __builtin_amdgcn_rcpf(1.0f + __builtin_amdgcn_exp2f(-1.4426950408889634f * x)); }
__device__ __forceinline__ float fsilu(float x) { return x * fsigmoid(x); }
__device__ __forceinline__ float flogsig16(float x) {
    const float ax = __builtin_fabsf(x);
    const float l = __builtin_amdgcn_logf(1.0f + __builtin_amdgcn_exp2f(-1.4426950408889634f * ax)) * 0.6931471805599453f;
    return (__builtin_fminf(x, 0.0f) - l) * 0.0625f;
}
__device__ __forceinline__ float bflo(unsigned w) { return __uint_as_float(w << 16); }
__device__ __forceinline__ float bfhi(unsigned w) { return __uint_as_float(w & 0xffff0000u); }

struct EpiProj {
    static constexpr bool PERM = true, AFTER_DRAIN = false, HAS_MID = false;
    bf16_t* QKV; bf16_t* PJ; const float* gbias;
    const float* cs; const float* qg; const float* kg; PG8_LAS float* X;
    __device__ __forceinline__ void mid(f32x4 (&acc)[2][2][4][2], const Unit& u, int wr, int wc, int fr, int fq) const {}
    __device__ __forceinline__ void operator()(const f32x4 (&acc)[2][2][4][2], const Unit& u, int wr, int wc, int fr, int fq) const {
        const int row0 = u.pm * BM + wr * 64 + fr, col0 = u.pn * BM + wc * 32 + 8 * fq;
        const int mode = u.pn < 20 ? 0 : (u.pn < 24 ? 1 : (u.pn < 40 ? 2 : 3));
        const bool isqkv = u.pn < 12;
        bf16_t* const O = isqkv ? QKV + (size_t)(u.pn >> 2) * ((size_t)32 << 20) + ((u.pn & 3) * BM + wc * 32 + 8 * fq) : PJ + ((u.pn - 12) * BM + wc * 32 + 8 * fq);
        const int ldc = isqkv ? 1024 : 7680;
        if (u.pn < 8) {
            const bool isq = u.pn < 4; const float* gg = isq ? qg : kg;
            asm volatile("" : "+v"(fr), "+v"(fq));
#pragma unroll
            for (int ai = 0; ai < 2; ++ai)
#pragma unroll
                for (int m = 0; m < 4; ++m)
#pragma unroll
                    for (int bj = 0; bj < 2; ++bj) { const f32x4 a = acc[ai][bj][m][0], b = acc[ai][bj][m][1];
                        float t = (a[0] * a[0] + a[1] * a[1]) + (a[2] * a[2] + a[3] * a[3]) + (b[0] * b[0] + b[1] * b[1]) + (b[2] * b[2] + b[3] * b[3]);
                        t += __shfl_xor(t, 16); t += __shfl_xor(t, 32);
                        if (fq == 0) X[((ai * HALF + wr * 64 + m * 16 + fr) * 2 + bj) * 4 + wc] = t; }
            asm volatile("s_waitcnt lgkmcnt(0)\n\ts_barrier" ::: "memory");
            const f32x4 g0 = *(const f32x4*)(gg + 32 * (wc & 1) + 8 * fq), g1 = *(const f32x4*)(gg + 32 * (wc & 1) + 8 * fq + 4);
            const bool ropew = (wc & 1) == 0; const float sgn = (fq == 0) ? -1.0f : 1.0f; const bool ropel = ropew && fq < 2;
            const float qs = isq ? (0.125f * 1.4426950408889634f) : 1.0f;
#pragma unroll
            for (int ai = 0; ai < 2; ++ai)
#pragma unroll
                for (int m = 0; m < 4; ++m) { const int rt = ai * HALF + wr * 64 + m * 16 + fr; const size_t row = (size_t)(u.pm * BM + rt);
                    f32x4 c0 = (f32x4){1.f, 1.f, 1.f, 1.f}, c1 = c0, s0 = (f32x4){0.f, 0.f, 0.f, 0.f}, s1 = s0;
                    if (ropel) { const f32x4* cp = (const f32x4*)(cs + row * 16); c0 = cp[0]; c1 = cp[1]; s0 = cp[2] * sgn; s1 = cp[3] * sgn; }
                    bf16_t* rowp = O + row * ldc;
#pragma unroll
                    for (int bj = 0; bj < 2; ++bj) { const float tot = X[(rt * 2 + bj) * 4 + wc] + X[(rt * 2 + bj) * 4 + (wc ^ 1)];
                        const float rstd = 1.0f / sqrtf(tot * (1.0f / 64.0f) + 1e-6f);
                        f32x4 v0 = acc[ai][bj][m][0] * rstd * g0, v1 = acc[ai][bj][m][1] * rstd * g1;
                        f32x4 o0, o1;
#pragma unroll
                        for (int e = 0; e < 4; ++e) { o0[e] = __shfl_xor(v0[e], 16); o1[e] = __shfl_xor(v1[e], 16); }
                        if (ropew) { v0 = v0 * c0 + o0 * s0; v1 = v1 * c1 + o1 * s1; }
                        v0 = v0 * qs; v1 = v1 * qs;
                        u32x4 w; w.x = cvt_pk_bf16(v0[0], v0[1]); w.y = cvt_pk_bf16(v0[2], v0[3]); w.z = cvt_pk_bf16(v1[0], v1[1]); w.w = cvt_pk_bf16(v1[2], v1[3]);
                        *(u32x4*)(rowp + bj * HALF) = w; } }
            return;
        }
        f32x4 bv[2][2];
#pragma unroll
        for (int bj = 0; bj < 2; ++bj)
#pragma unroll
            for (int n = 0; n < 2; ++n) bv[bj][n] = (mode == 3) ? *(const f32x4*)(gbias + (col0 - 10240) + bj * HALF + 4 * n) : (f32x4){0.f, 0.f, 0.f, 0.f};
#pragma unroll
        for (int ai = 0; ai < 2; ++ai)
#pragma unroll
            for (int m = 0; m < 4; ++m) { bf16_t* rowp = O + (size_t)(row0 + ai * HALF + m * 16) * ldc;
#pragma unroll
                for (int bj = 0; bj < 2; ++bj) { f32x4 v0 = acc[ai][bj][m][0], v1 = acc[ai][bj][m][1];
                    if (mode == 1) {
#pragma unroll
                        for (int e = 0; e < 4; ++e) { v0[e] = fsilu(v0[e]); v1[e] = fsilu(v1[e]); }
                    } else if (mode == 2) {
#pragma unroll
                        for (int e = 0; e < 4; ++e) { v0[e] = fsigmoid(v0[e]); v1[e] = fsigmoid(v1[e]); }
                    } else if (mode == 3) { v0 = v0 + bv[bj][0]; v1 = v1 + bv[bj][1];
#pragma unroll
                        for (int e = 0; e < 4; ++e) { v0[e] = flogsig16(v0[e]); v1[e] = flogsig16(v1[e]); }
                    }
                    u32x4 w; w.x = cvt_pk_bf16(v0[0], v0[1]); w.y = cvt_pk_bf16(v0[2], v0[3]); w.z = cvt_pk_bf16(v1[0], v1[1]); w.w = cvt_pk_bf16(v1[2], v1[3]);
                    *(u32x4*)(rowp + bj * HALF) = w; } }
    }
};

struct EpiMerge {
    static constexpr bool PERM = true, AFTER_DRAIN = false, HAS_MID = true;
    bf16_t* O; int ldc; const bf16_t* G; int ldg;
    __device__ __forceinline__ void mid(f32x4 (&acc)[2][2][4][2], const Unit& u, int wr, int wc, int fr, int fq) const {
        int fr_ = fr, fq_ = fq; asm volatile("" : "+v"(fr_), "+v"(fq_));
        const int row0 = u.pm * BM + wr * 64 + fr_, col0 = u.pn * BM + wc * 32 + 8 * fq_;
#pragma unroll
        for (int ai = 0; ai < 2; ++ai)
#pragma unroll
            for (int m = 0; m < 4; ++m) { const bf16_t* gp = G + (size_t)(row0 + ai * HALF + m * 16) * ldg + col0;
#pragma unroll
                for (int bj = 0; bj < 2; ++bj) { const u32x4 a = *(const u32x4*)(gp + 3072 + bj * HALF), b = *(const u32x4*)(gp + 5120 + bj * HALF);
                    f32x4 r0, r1;
                    r0[0] = bflo(a.x) * __builtin_amdgcn_rcpf(bflo(b.x)); r0[1] = bfhi(a.x) * __builtin_amdgcn_rcpf(bfhi(b.x)); r0[2] = bflo(a.y) * __builtin_amdgcn_rcpf(bflo(b.y)); r0[3] = bfhi(a.y) * __builtin_amdgcn_rcpf(bfhi(b.y));
                    r1[0] = bflo(a.z) * __builtin_amdgcn_rcpf(bflo(b.z)); r1[1] = bfhi(a.z) * __builtin_amdgcn_rcpf(bfhi(b.z)); r1[2] = bflo(a.w) * __builtin_amdgcn_rcpf(bflo(b.w)); r1[3] = bfhi(a.w) * __builtin_amdgcn_rcpf(bfhi(b.w));
                    acc[ai][bj][m][0] = acc[ai][bj][m][0] * r0; acc[ai][bj][m][1] = acc[ai][bj][m][1] * r1;
                    asm volatile("" : "+v"(acc[ai][bj][m][0]), "+v"(acc[ai][bj][m][1]) :: "memory"); } }
    }
    __device__ __forceinline__ void operator()(const f32x4 (&acc)[2][2][4][2], const Unit& u, int wr, int wc, int fr, int fq) const {
        const int row0 = u.pm * BM + wr * 64 + fr, col0 = u.pn * BM + wc * 32 + 8 * fq;
#pragma unroll
        for (int ai = 0; ai < 2; ++ai)
#pragma unroll
            for (int m = 0; m < 4; ++m) { const size_t r = (size_t)(row0 + ai * HALF + m * 16); const bf16_t* gp = G + r * ldg + col0; bf16_t* rowp = O + r * ldc + col0;
#pragma unroll
                for (int bj = 0; bj < 2; ++bj) { const u32x4 b = *(const u32x4*)(gp + 5120 + bj * HALF);
                    const f32x4 v0 = acc[ai][bj][m][0], v1 = acc[ai][bj][m][1];
                    u32x4 w; w.x = cvt_pk_bf16(v0[0] * bflo(b.x), v0[1] * bfhi(b.x)); w.y = cvt_pk_bf16(v0[2] * bflo(b.y), v0[3] * bfhi(b.y));
                    w.z = cvt_pk_bf16(v1[0] * bflo(b.z), v1[1] * bfhi(b.z)); w.w = cvt_pk_bf16(v1[2] * bflo(b.w), v1[3] * bfhi(b.w));
                    *(u32x4*)(rowp + bj * HALF) = w; } }
    }
};

template <bool BASE16, bool OUT16> struct EpiRes {
    static constexpr bool PERM = true, AFTER_DRAIN = false, HAS_MID = false;
    const void* base; void* out; int ldc; const float* mod; const float* bada; int goff; int rows_per_batch;
    __device__ __forceinline__ void mid(f32x4 (&acc)[2][2][4][2], const Unit& u, int wr, int wc, int fr, int fq) const {}
    __device__ __forceinline__ void operator()(const f32x4 (&acc)[2][2][4][2], const Unit& u, int wr, int wc, int fr, int fq) const {
        const int row0 = u.pm * BM + wr * 64 + fr, col0 = u.pn * BM + wc * 32 + 8 * fq;
        const int b = (u.pm * BM) / rows_per_batch;
        f32x4 gv[2][2];
#pragma unroll
        for (int bj = 0; bj < 2; ++bj)
#pragma unroll
            for (int n = 0; n < 2; ++n) gv[bj][n] = *(const f32x4*)(mod + b * 12288 + goff + col0 + bj * HALF + 4 * n) + *(const f32x4*)(bada + goff + col0 + bj * HALF + 4 * n);
#pragma unroll
        for (int ai = 0; ai < 2; ++ai)
#pragma unroll
            for (int m = 0; m < 4; ++m) { const size_t off = (size_t)(row0 + ai * HALF + m * 16) * ldc + col0;
#pragma unroll
                for (int bj = 0; bj < 2; ++bj) {
                    f32x4 b0, b1;
                    if constexpr (BASE16) { const u32x4 w = *(const u32x4*)((const bf16_t*)base + off + bj * HALF);
                        b0 = (f32x4){bflo(w.x), bfhi(w.x), bflo(w.y), bfhi(w.y)}; b1 = (f32x4){bflo(w.z), bfhi(w.z), bflo(w.w), bfhi(w.w)}; }
                    else { b0 = *(const f32x4*)((const float*)base + off + bj * HALF); b1 = *(const f32x4*)((const float*)base + off + bj * HALF + 4); }
                    const f32x4 o0 = b0 + gv[bj][0] * acc[ai][bj][m][0], o1 = b1 + gv[bj][1] * acc[ai][bj][m][1];
                    if constexpr (OUT16) { u32x4 w; w.x = cvt_pk_bf16(o0[0], o0[1]); w.y = cvt_pk_bf16(o0[2], o0[3]); w.z = cvt_pk_bf16(o1[0], o1[1]); w.w = cvt_pk_bf16(o1[2], o1[3]);
                        *(u32x4*)((bf16_t*)out + off + bj * HALF) = w; }
                    else { *(f32x4*)((float*)out + off + bj * HALF) = o0; *(f32x4*)((float*)out + off + bj * HALF + 4) = o1; } } }
    }
};

struct EpiRelu2 {
    static constexpr bool PERM = true, AFTER_DRAIN = false, HAS_MID = false;
    bf16_t* O; int ldc;
    __device__ __forceinline__ void mid(f32x4 (&acc)[2][2][4][2], const Unit& u, int wr, int wc, int fr, int fq) const {}
    __device__ __forceinline__ void operator()(const f32x4 (&acc)[2][2][4][2], const Unit& u, int wr, int wc, int fr, int fq) const {
        const int row0 = u.pm * BM + wr * 64 + fr, col0 = u.pn * BM + wc * 32 + 8 * fq;
#pragma unroll
        for (int ai = 0; ai < 2; ++ai)
#pragma unroll
            for (int m = 0; m < 4; ++m) { bf16_t* rowp = O + (size_t)(row0 + ai * HALF + m * 16) * ldc + col0;
#pragma unroll
                for (int bj = 0; bj < 2; ++bj) { f32x4 v0 = acc[ai][bj][m][0], v1 = acc[ai][bj][m][1];
#pragma unroll
                    for (int e = 0; e < 4; ++e) { const float a = __builtin_fmaxf(v0[e], 0.f), b = __builtin_fmaxf(v1[e], 0.f); v0[e] = a * a; v1[e] = b * b; }
                    u32x4 w; w.x = cvt_pk_bf16(v0[0], v0[1]); w.y = cvt_pk_bf16(v0[2], v0[3]); w.z = cvt_pk_bf16(v1[0], v1[1]); w.w = cvt_pk_bf16(v1[2], v1[3]);
                    *(u32x4*)(rowp + bj * HALF) = w; } }
    }
};

template <class Epi, class Sched, bool ALIGN_EPI = false, bool SP2 = false>
__device__ __forceinline__ void gemm_phase(PG8_LAS unsigned char* lds, const Gemm g, const Sched& S, const Epi& E) {
    const int tid = threadIdx.x, wid = __builtin_amdgcn_readfirstlane(tid >> 6), lane = tid & 63, wr = wid >> 2, wc = wid & 3, fr = lane & 15, fq = lane >> 4;
    const int K = g.K, nt = K / BK;
    unsigned voffA[2], voffB[2];
#pragma unroll
    for (int i = 0; i < 2; ++i) { int R, C; stage_rc(tid * 16 + i * 8192, R, C); const int Rb = Epi::PERM ? ((R & ~31) + perm32(R & 31)) : R;
        voffA[i] = (unsigned)(R * K + C) * 2u; voffB[i] = (unsigned)(Rb * K + C) * 2u; }
    const size_t kstep = (size_t)(BK * 2);
    const size_t hstep = (size_t)HALF * K * 2;
    const size_t tstep = 2 * hstep;
    const unsigned ldsw = (unsigned)wid * 1024u;
    const int aoff = lds_byte(wr * 64 + fr, fq * 8), boff = lds_byte(wc * 32 + fr, fq * 8);
#define PG8_SA(b, h) (((b) * 2 + (h)) * HTB)
#define PG8_SB(b, h) ((4 + (b) * 2 + (h)) * HTB)
#define PG8_STAGE(bufoff, gbase, voff) do { _Pragma("unroll") for (int _i = 0; _i < 2; ++_i) \
        __builtin_amdgcn_global_load_lds((const unsigned*)((const char*)(gbase) + (voff)[_i]), (PG8_LAS unsigned*)(lds + (bufoff) + ldsw + _i * 8192), 16, 0, 0); } while (0)
#define PG8_LDA(dst, b, h) do { _Pragma("unroll") for (int m = 0; m < 4; ++m) _Pragma("unroll") for (int k = 0; k < 2; ++k) dst[m][k] = *(const PG8_LAS bf16x8*)(lds + PG8_SA(b, h) + aoff + m * 2048 + k * 1024); } while (0)
#define PG8_LDB(dst, b, h) do { _Pragma("unroll") for (int n = 0; n < 2; ++n) _Pragma("unroll") for (int k = 0; k < 2; ++k) dst[n][k] = *(const PG8_LAS bf16x8*)(lds + PG8_SB(b, h) + boff + n * 2048 + k * 1024); } while (0)
#define PG8_MMA(ai, bj, At, Bt) do { __builtin_amdgcn_s_setprio(1); _Pragma("unroll") for (int m = 0; m < 4; ++m) _Pragma("unroll") for (int n = 0; n < 2; ++n) _Pragma("unroll") for (int k = 0; k < 2; ++k) \
        acc[ai][bj][m][n] = __builtin_amdgcn_mfma_f32_16x16x32_bf16(Bt[n][k], At[m][k], acc[ai][bj][m][n], 0, 0, 0); __builtin_amdgcn_s_setprio(0); } while (0)
#define PG8_WAIT_V(n) asm volatile("s_waitcnt vmcnt(" #n ")" ::: "memory")
#define PG8_WAIT_L(n) asm volatile("s_waitcnt lgkmcnt(" #n ")" ::: "memory")
#define PG8_BAR __builtin_amdgcn_s_barrier()
#define PG8_SCHED __builtin_amdgcn_sched_barrier(0)
    Unit cur, nxt; int ui = 0;
    if (!S.next(0, cur)) return;
    f32x4 acc[2][2][4][2];
#pragma unroll
    for (int a = 0; a < 2; ++a)
#pragma unroll
        for (int b = 0; b < 2; ++b)
#pragma unroll
            for (int m = 0; m < 4; ++m)
#pragma unroll
                for (int n = 0; n < 2; ++n) acc[a][b][m][n] = (f32x4){0.f, 0.f, 0.f, 0.f};
    bf16x8 At[4][2], B0[2][2], B1[2][2];
    const char* cA = (const char*)g.A + (size_t)cur.pm * tstep; const char* cB = (const char*)g.Bt + (size_t)cur.pn * tstep;
    S.a_ready(cur);
    if constexpr (SP2) {
        PG8_STAGE(PG8_SB(0, 0), cB, voffB); PG8_STAGE(PG8_SB(0, 1), cB + hstep, voffB); PG8_STAGE(PG8_SA(0, 0), cA, voffA); PG8_STAGE(PG8_SA(0, 1), cA + hstep, voffA);
        if (wr == 1) PG8_BAR;
        PG8_WAIT_V(2); PG8_BAR;
        PG8_STAGE(PG8_SB(1, 0), cB + kstep, voffB); PG8_STAGE(PG8_SA(1, 0), cA + kstep, voffA); PG8_STAGE(PG8_SB(1, 1), cB + hstep + kstep, voffB);
        PG8_WAIT_V(6); PG8_BAR;
    } else {
        PG8_STAGE(PG8_SB(0, 0), cB, voffB); PG8_STAGE(PG8_SA(0, 0), cA, voffA); PG8_STAGE(PG8_SB(0, 1), cB + hstep, voffB); PG8_STAGE(PG8_SA(0, 1), cA + hstep, voffA);
        if (wr == 1) PG8_BAR;
        PG8_WAIT_V(4); PG8_BAR;
        PG8_STAGE(PG8_SB(1, 0), cB + kstep, voffB); PG8_STAGE(PG8_SA(1, 0), cA + kstep, voffA); PG8_STAGE(PG8_SB(1, 1), cB + hstep + kstep, voffB);
        PG8_WAIT_V(6); PG8_BAR;
    }
    for (;;) {
        const bool has_next = S.next(ui + 1, nxt);
        const char* nA = has_next ? (const char*)g.A + (size_t)nxt.pm * tstep : cA; const char* nB = has_next ? (const char*)g.Bt + (size_t)nxt.pn * tstep : cB;
        for (int t = 0; t < nt; t += 2) {
            if constexpr (Epi::HAS_MID) { if (t == (nt >> 1)) E.mid(acc, cur, wr, wc, fr, fq); }
            const bool last = (t == nt - 2);
            const char* a1 = cA + (size_t)(t + 1) * kstep;
            const char* a2 = last ? nA : cA + (size_t)(t + 2) * kstep; const char* b2 = last ? nB : cB + (size_t)(t + 2) * kstep;
            const char* a3 = a2 + kstep; const char* b3 = b2 + kstep;
            if (last && has_next) S.a_ready(nxt);
            if constexpr (SP2) {
            PG8_LDB(B0, 0, 0); PG8_LDB(B1, 0, 1); PG8_SCHED; PG8_LDA(At, 0, 0); PG8_STAGE(PG8_SA(1, 1), a1 + hstep, voffA);
            PG8_WAIT_V(8); PG8_WAIT_L(0); PG8_BAR; PG8_MMA(0, 0, At, B0); PG8_MMA(0, 1, At, B1); PG8_BAR; PG8_SCHED;
            PG8_LDA(At, 0, 1); PG8_STAGE(PG8_SB(0, 0), b2, voffB); PG8_STAGE(PG8_SB(0, 1), b2 + hstep, voffB); PG8_STAGE(PG8_SA(0, 0), a2, voffA);
            PG8_WAIT_V(8); PG8_WAIT_L(0); PG8_BAR; PG8_MMA(1, 0, At, B0); PG8_MMA(1, 1, At, B1); PG8_BAR; PG8_SCHED;
            PG8_LDB(B0, 1, 0); PG8_LDB(B1, 1, 1); PG8_SCHED; PG8_LDA(At, 1, 0); PG8_STAGE(PG8_SA(0, 1), a2 + hstep, voffA);
            PG8_WAIT_V(8); PG8_WAIT_L(0); PG8_BAR; PG8_MMA(0, 0, At, B0); PG8_MMA(0, 1, At, B1); PG8_BAR; PG8_SCHED;
            PG8_LDA(At, 1, 1); PG8_STAGE(PG8_SB(1, 0), b3, voffB); PG8_STAGE(PG8_SB(1, 1), b3 + hstep, voffB); PG8_STAGE(PG8_SA(1, 0), a3, voffA);
            PG8_WAIT_V(8); PG8_WAIT_L(0); PG8_BAR; PG8_MMA(1, 0, At, B0); PG8_MMA(1, 1, At, B1); PG8_BAR; PG8_SCHED;
            } else {
            PG8_LDB(B0, 0, 0); PG8_SCHED; PG8_LDA(At, 0, 0); PG8_STAGE(PG8_SA(1, 1), a1 + hstep, voffA);
            PG8_WAIT_L(8); PG8_BAR; PG8_WAIT_L(0); PG8_MMA(0, 0, At, B0); PG8_BAR; PG8_SCHED;
            PG8_LDB(B1, 0, 1); PG8_STAGE(PG8_SB(0, 0), b2, voffB);
            PG8_BAR; PG8_WAIT_L(0); PG8_MMA(0, 1, At, B1); PG8_BAR;
            PG8_LDA(At, 0, 1); PG8_STAGE(PG8_SA(0, 0), a2, voffA);
            PG8_BAR; PG8_WAIT_L(0); PG8_MMA(1, 0, At, B0); PG8_BAR; PG8_SCHED;
            PG8_STAGE(PG8_SB(0, 1), b2 + hstep, voffB);
            PG8_WAIT_V(6); PG8_BAR; PG8_MMA(1, 1, At, B1); PG8_BAR;
            PG8_LDB(B0, 1, 0); PG8_SCHED; PG8_LDA(At, 1, 0); PG8_STAGE(PG8_SA(0, 1), a2 + hstep, voffA);
            PG8_WAIT_L(8); PG8_BAR; PG8_WAIT_L(0); PG8_MMA(0, 0, At, B0); PG8_BAR; PG8_SCHED;
            PG8_LDB(B1, 1, 1); PG8_STAGE(PG8_SB(1, 0), b3, voffB);
            PG8_BAR; PG8_WAIT_L(0); PG8_MMA(0, 1, At, B1); PG8_BAR;
            PG8_LDA(At, 1, 1); PG8_STAGE(PG8_SA(1, 0), a3, voffA);
            PG8_BAR; PG8_WAIT_L(0); PG8_MMA(1, 0, At, B0); PG8_BAR; PG8_SCHED;
            PG8_STAGE(PG8_SB(1, 1), b3 + hstep, voffB);
            PG8_WAIT_V(6); PG8_BAR; PG8_MMA(1, 1, At, B1); PG8_BAR;
            }
        }
        if constexpr (ALIGN_EPI) { if (wr == 0) PG8_BAR; }
        if constexpr (!Epi::AFTER_DRAIN) { E(acc, cur, wr, wc, fr, fq); S.done(cur); }
        if (!has_next) break;
#pragma unroll
        for (int a = 0; a < 2; ++a)
#pragma unroll
            for (int b = 0; b < 2; ++b)
#pragma unroll
                for (int m = 0; m < 4; ++m)
#pragma unroll
                    for (int n = 0; n < 2; ++n) acc[a][b][m][n] = (f32x4){0.f, 0.f, 0.f, 0.f};
        cur = nxt; cA = nA; cB = nB; ++ui;
        if constexpr (ALIGN_EPI) { if (wr == 1) PG8_BAR; }
    }
    PG8_WAIT_V(0);
    if constexpr (!ALIGN_EPI) { if (wr == 0) PG8_BAR; }
    PG8_BAR;
    if constexpr (Epi::AFTER_DRAIN) { E.fused(acc, cur, wr, wc, fr, fq, lds, wid, lane); S.done(cur); }
#undef PG8_SA
#undef PG8_SB
#undef PG8_STAGE
#undef PG8_LDA
#undef PG8_LDB
#undef PG8_MMA
#undef PG8_WAIT_V
#undef PG8_WAIT_L
#undef PG8_BAR
#undef PG8_SCHED
}
}

#ifndef PG8_SP2
#define PG8_SP2 true
#endif
#include <hip/hip_bf16.h>
#include <cmath>
namespace attn_body {
using bf16=__hip_bfloat16;
using bf16x8=__attribute__((ext_vector_type(8)))short;
using s16x4=__attribute__((ext_vector_type(4)))short;
using f32x16=__attribute__((ext_vector_type(16)))float;
using u32x4=__attribute__((ext_vector_type(4)))unsigned;
constexpr int SEQ=16384,D=64,DM=1024,OPITCH=2048;
constexpr int NW=8,QBLK=32,QB=QBLK*NW,KVBLK=64,NQB=SEQ/QB;
__device__ __forceinline__ int crow(int r,int hi){return (r&3)+8*(r>>2)+4*hi;}
#define SBAR() __builtin_amdgcn_sched_barrier(0)
__device__ __forceinline__ void cmask(f32x16&p0,f32x16&p1,int jb,int qrel,int hi){
  const float NEG=-INFINITY; int kb=64*jb+4*hi;
  #pragma unroll
  for(int r=0;r<16;++r){int kv=kb+(r&3)+8*(r>>2); if(kv>qrel)p0[r]=NEG; if(kv+32>qrel)p1[r]=NEG;}
}

constexpr int NSLOT=3, SLOTB=8192;
constexpr int VSLOTB=16384;
constexpr int LDS_K=0, LDS_V=NSLOT*SLOTB, LDS_WS=LDS_V+NSLOT*VSLOTB, LDS_OST=LDS_WS+NW*64*4, LDS_BYTES=LDS_OST+NW*4096;
constexpr float C2=0.125f*1.4426950408889634f;
__device__ __forceinline__ void glds16(const void*gsrc,unsigned lds_dst){unsigned keep;
  asm volatile("s_mov_b32 %0, m0\n\ts_mov_b32 m0, %2\n\ts_nop 0\n\tglobal_load_lds_dwordx4 %1, off\n\ts_mov_b32 m0, %0":"=&s"(keep):"v"(gsrc),"s"(lds_dst):"memory");}
__device__ __forceinline__ float max3f(float a,float b,float c){float r;asm("v_max3_f32 %0, %1, %2, %3":"=v"(r):"v"(a),"v"(b),"v"(c));return r;}
__device__ __forceinline__ float max2f(float a,float b){float r;asm("v_max_f32_e32 %0, %1, %2":"=v"(r):"v"(a),"v"(b));return r;}
__device__ __forceinline__ float fadd_s(float a,float b){float r;asm("v_add_f32_e32 %0, %1, %2":"=v"(r):"v"(a),"v"(b));return r;}
__device__ __forceinline__ float fsub_s(float a,float b){float r;asm("v_sub_f32_e32 %0, %1, %2":"=v"(r):"v"(a),"v"(b));return r;}
typedef float f32x2_t __attribute__((ext_vector_type(2))); typedef __bf16 bf16x2_t __attribute__((ext_vector_type(2)));
__device__ __forceinline__ unsigned cvtpk_s(float lo,float hi){f32x2_t v={lo,hi};bf16x2_t b=__builtin_convertvector(v,bf16x2_t);return __builtin_bit_cast(unsigned,b);}
#define WAIT_BAR(N) asm volatile("s_waitcnt vmcnt(" #N ") lgkmcnt(0)\n\ts_barrier":::"memory")

__device__ __forceinline__ void qkt(f32x16&p0,f32x16&p1,const char*Kslot,const bf16x8*qr,int r32,int hi){
  const f32x16 negm=f32x16{};
  const char*kb=Kslot+hi*1024+r32*16;
  #pragma unroll
  for(int d0=0;d0<4;++d0){
    const bf16x8 b0=*reinterpret_cast<const bf16x8*>(kb+d0*2048);
    const bf16x8 b1=*reinterpret_cast<const bf16x8*>(kb+d0*2048+512);
    if(d0==0){p0=__builtin_amdgcn_mfma_f32_32x32x16_bf16(b0,qr[0],negm,0,0,0);p1=__builtin_amdgcn_mfma_f32_32x32x16_bf16(b1,qr[0],negm,0,0,0);}
    else{p0=__builtin_amdgcn_mfma_f32_32x32x16_bf16(b0,qr[d0],p0,0,0,0);p1=__builtin_amdgcn_mfma_f32_32x32x16_bf16(b1,qr[d0],p1,0,0,0);}}
}
typedef __attribute__((address_space(3))) const char* lds_cptr;
typedef short v4i16_t __attribute__((ext_vector_type(4)));
__device__ __forceinline__ void kload8(bf16x8*kf,lds_cptr kp){
  kf[0]=*(const __attribute__((address_space(3))) bf16x8*)(kp);      kf[1]=*(const __attribute__((address_space(3))) bf16x8*)(kp+512);
  kf[2]=*(const __attribute__((address_space(3))) bf16x8*)(kp+2048); kf[3]=*(const __attribute__((address_space(3))) bf16x8*)(kp+2560);
  kf[4]=*(const __attribute__((address_space(3))) bf16x8*)(kp+4096); kf[5]=*(const __attribute__((address_space(3))) bf16x8*)(kp+4608);
  kf[6]=*(const __attribute__((address_space(3))) bf16x8*)(kp+6144); kf[7]=*(const __attribute__((address_space(3))) bf16x8*)(kp+6656);
}
__device__ __forceinline__ void kload2(bf16x8*kf,lds_cptr kp,int j){ kf[2*j]=*(const __attribute__((address_space(3))) bf16x8*)(kp+j*2048); kf[2*j+1]=*(const __attribute__((address_space(3))) bf16x8*)(kp+j*2048+512); }
__device__ __forceinline__ s16x4 vtr(lds_cptr p){ return __builtin_bit_cast(s16x4,__builtin_amdgcn_ds_read_tr16_b64_v4i16((__attribute__((address_space(3))) v4i16_t*)p)); }
__device__ __forceinline__ float rowmax(const f32x16&p0,const f32x16&p1){
  float a=max3f(p0[0],p0[1],p1[0]),b=max3f(p0[2],p0[3],p1[1]);a=max3f(a,p1[2],p1[3]);
  #pragma unroll
  for(int r=4;r<16;r+=4){a=max3f(a,p0[r],p0[r+1]);b=max3f(b,p0[r+2],p0[r+3]);a=max3f(a,p1[r],p1[r+1]);b=max3f(b,p1[r+2],p1[r+3]);}
  const float m=max2f(a,b);
  auto rr=__builtin_amdgcn_permlane32_swap(__float_as_uint(m),__float_as_uint(m),false,false);
  return max2f(__uint_as_float(rr[0]),__uint_as_float(rr[1]));
}
__device__ __forceinline__ void pv(f32x16*o,int vb,bf16x8 pa0,bf16x8 pa1,bf16x8 pa2,bf16x8 pa3){
  #pragma unroll
  for(int d0=0;d0<4;++d0){s16x4 lo[4],hi[4];
    #pragma unroll
    for(int ks=0;ks<4;++ks){
      asm volatile("ds_read_b64_tr_b16 %0,%1 offset:%c2":"=&v"(lo[ks]):"v"(vb),"i"(d0*4096+ks*1024):"memory");
      asm volatile("ds_read_b64_tr_b16 %0,%1 offset:%c2":"=&v"(hi[ks]):"v"(vb),"i"(d0*4096+ks*1024+512):"memory");}
    asm volatile("s_waitcnt lgkmcnt(0)":::"memory");SBAR();
    #define PK(k) (bf16x8){lo[k][0],lo[k][1],lo[k][2],lo[k][3],hi[k][0],hi[k][1],hi[k][2],hi[k][3]}
    o[d0]=__builtin_amdgcn_mfma_f32_32x32x16_bf16(pa0,PK(0),o[d0],0,0,0);
    o[d0]=__builtin_amdgcn_mfma_f32_32x32x16_bf16(pa1,PK(1),o[d0],0,0,0);
    o[d0]=__builtin_amdgcn_mfma_f32_32x32x16_bf16(pa2,PK(2),o[d0],0,0,0);
    o[d0]=__builtin_amdgcn_mfma_f32_32x32x16_bf16(pa3,PK(3),o[d0],0,0,0);
    #undef PK
  }
}

#ifndef ATTN_STORE16
#define ATTN_STORE16(p,v) (*(u32x4*)(p)=(v))
#endif
template<int THRL> __device__ __forceinline__ void attn_unit(int b,int qcol,int kcol,int vcol,int ocol,int qb,const bf16*Q,const bf16*__restrict__ K,const bf16*__restrict__ V,bf16*O,char*shm){
  int tid_=threadIdx.x; asm volatile("":"+v"(tid_));
  const int tid=tid_,lane=tid&63,r32=lane&31,hi=lane>>5; const int wid=__builtin_amdgcn_readfirstlane(tid>>6);
  const long rowbase=(long)b*SEQ; const int q0=qb*QB;
  const bf16*Qw=Q+(rowbase+q0+wid*QBLK)*DM+qcol;
  const bf16*Kh=K+rowbase*DM+kcol,*Vh=V+rowbase*DM+vcol;
  const unsigned lds0=(unsigned)(uintptr_t)shm;
  float*wsf=(float*)(shm+LDS_WS)+wid*64;
  const bf16*ksrc=Kh+(long)lane*DM+wid*8;
  const bf16*vsrc=Vh+(long)(16*(wid&3)+(lane>>2))*DM+(wid>>2)*32+(lane&3)*8;
  const unsigned kdst=lds0+LDS_K+wid*1024, vdst=lds0+LDS_V+wid*1024;
  #define DMA_K(t,slot) glds16(ksrc+(long)(t)*KVBLK*DM,(unsigned)__builtin_amdgcn_readfirstlane(kdst+(slot)))
  #define DMA_V(t,slot) do{ glds16(vsrc+(long)(t)*KVBLK*DM,(unsigned)__builtin_amdgcn_readfirstlane(vdst+2*(slot))); glds16(vsrc+(long)(t)*KVBLK*DM+64,(unsigned)__builtin_amdgcn_readfirstlane(vdst+2*(slot)+8192)); }while(0)
  const int vb0=(int)(lds0+LDS_V)+((lane>>4)&1)*32+(lane&3)*8+(4*hi+((lane&15)>>2))*64;
  const char*Kbase=shm+LDS_K; bf16x8 kf[8];
  const lds_cptr shm3=(lds_cptr)shm; const lds_cptr kp0=shm3+LDS_K+hi*1024+r32*16; const lds_cptr vp0=shm3+LDS_V+((lane>>4)&1)*32+(lane&3)*8+(4*hi+((lane&15)>>2))*64;
  const int NT=(q0+QB)/KVBLK;
  DMA_K(0,0);DMA_V(0,0);DMA_K(1,SLOTB);
  bf16x8 qr[4];
  #pragma unroll
  for(int d0=0;d0<4;++d0)qr[d0]=*reinterpret_cast<const bf16x8*>(&Qw[(long)r32*DM+d0*16+hi*8]);
  float l_reg=0.f;f32x16 o[4];o[0]=f32x16{};o[1]=f32x16{};o[2]=f32x16{};o[3]=f32x16{};
  const int qrel=wid*QBLK+r32;
  #define CMASK(P0,P1,t) do{int jb_=(t)-(NT-4); if(jb_>=0)cmask(P0,P1,jb_,qrel,hi);}while(0)
  f32x16 pA0,pA1,pB0,pB1;
  int sl_prev=0,sl_cur=0,sl_next=SLOTB;
  #define ROT() do{sl_prev=sl_cur;sl_cur=sl_next;sl_next=(sl_next==(NSLOT-1)*SLOTB)?0:sl_next+SLOTB;}while(0)
  DMA_K(2,2*SLOTB);
  WAIT_BAR(3);
  qkt(pA0,pA1,Kbase,qr,r32,hi);asm volatile("s_nop 15\n\ts_nop 7":"+v"(pA0),"+v"(pA1));CMASK(pA0,pA1,0);
  _Pragma("unroll") for(int r=0;r<16;++r){pA0[r]=__builtin_amdgcn_exp2f(pA0[r]);pA1[r]=__builtin_amdgcn_exp2f(pA1[r]);}
  WAIT_BAR(0);
  DMA_K(3,0);DMA_V(1,SLOTB);
  ROT();
  kload8(kf,kp0+sl_cur);
  WAIT_BAR(3);
  s16x4 vlo[8],vhi[8]; u32x4 pw0,pw1,pw2,pw3;
  #define PKW(P,B) cvtpk_s(P[B],P[B+1])
  #define PAF(k) __builtin_bit_cast(bf16x8,pw##k)
  #define VFR(i) (bf16x8){vlo[i][0],vlo[i][1],vlo[i][2],vlo[i][3],vhi[i][0],vhi[i][1],vhi[i][2],vhi[i][3]}
  #define PIN(x) asm volatile("":"+v"(x))
  #define MX3(a,b,c) __builtin_fmaxf(__builtin_fmaxf((a),(b)),(c))
  #define GAPA(MF,A0,A1,A2,A3,W0,W1,PW) do{ MF; sacc+=A0; sacc+=A1; sacc+=A2; sacc+=A3; PIN(sacc); W0; W1; PIN(PW); SBAR(); }while(0)
  #define EX(v) __builtin_amdgcn_exp2f(v)
  #define GAPB(MF,X,B) do{ MF; X[B]=EX(X[B]); X[B+1]=EX(X[B+1]); PIN(X); SBAR(); }while(0)
  #define VRD(i) do{ vlo[i]=vtr(vp_+(((i)>>2)*4096+((i)&3)*1024)); vhi[i]=vtr(vp_+(((i)>>2)*4096+((i)&3)*1024+512)); }while(0)
  #define VRD2(i) do{ vlo[i]=vtr(vp_+(8192+((i)>>2)*4096+((i)&3)*1024)); vhi[i]=vtr(vp_+(8192+((i)>>2)*4096+((i)&3)*1024+512)); SBAR(); }while(0)
  #define KRD(G,j) do{ if(G){ kload2(kf,kp0+sl_next,j); SBAR(); } }while(0)
  #define STEP(C0,C1,P0,P1,t,GK,GV,GL) do{ SBAR(); const f32x16 zero16=f32x16{}; \
    const lds_cptr vp_=vp0+2*sl_prev; \
    VRD(0); SBAR(); float sacc=(P0[0]+P0[1]); \
    GAPA(C0=__builtin_amdgcn_mfma_f32_32x32x16_bf16(kf[0],qr[0],zero16,0,0,0), P0[2],P0[3],P0[4],P0[5],     pw0[0]=PKW(P0,0), pw0[1]=PKW(P0,2), pw0); \
    VRD(4); SBAR(); GAPA(C1=__builtin_amdgcn_mfma_f32_32x32x16_bf16(kf[1],qr[0],zero16,0,0,0), P0[6],P0[7],P0[8],P0[9],     pw0[2]=PKW(P0,4), pw0[3]=PKW(P0,6), pw0); \
    VRD(1); SBAR(); GAPA(C0=__builtin_amdgcn_mfma_f32_32x32x16_bf16(kf[2],qr[1],C0,0,0,0),   P0[10],P0[11],P0[12],P0[13], pw1[0]=PKW(P0,8), pw1[1]=PKW(P0,10), pw1); \
    VRD(5); SBAR(); GAPA(C1=__builtin_amdgcn_mfma_f32_32x32x16_bf16(kf[3],qr[1],C1,0,0,0),   P0[14],P0[15],P1[0],P1[1],   pw1[2]=PKW(P0,12),pw1[3]=PKW(P0,14), pw1); \
    VRD(2); SBAR(); GAPA(C0=__builtin_amdgcn_mfma_f32_32x32x16_bf16(kf[4],qr[2],C0,0,0,0),   P1[2],P1[3],P1[4],P1[5],     pw2[0]=PKW(P1,0), pw2[1]=PKW(P1,2), pw2); \
    VRD(6); SBAR(); GAPA(C1=__builtin_amdgcn_mfma_f32_32x32x16_bf16(kf[5],qr[2],C1,0,0,0),   P1[6],P1[7],P1[8],P1[9],     pw2[2]=PKW(P1,4), pw2[3]=PKW(P1,6), pw2); \
    VRD(3); SBAR(); GAPA(C0=__builtin_amdgcn_mfma_f32_32x32x16_bf16(kf[6],qr[3],C0,0,0,0),   P1[10],P1[11],P1[12],P1[13], pw3[0]=PKW(P1,8), pw3[1]=PKW(P1,10), pw3); \
    VRD(7); SBAR(); GAPA(C1=__builtin_amdgcn_mfma_f32_32x32x16_bf16(kf[7],qr[3],C1,0,0,0),   P1[14],P1[15],0.f,0.f,       pw3[2]=PKW(P1,12),pw3[3]=PKW(P1,14), pw3); \
    l_reg+=sacc; \
    if(GK){DMA_K((t)+3,sl_cur);} if(GV){DMA_V((t)+1,sl_next);} \
    CMASK(C0,C1,t); \
    SBAR(); \
    GAPB(o[0]=__builtin_amdgcn_mfma_f32_32x32x16_bf16(PAF(0),VFR(0),o[0],0,0,0), C0,0); VRD2(0); \
    GAPB(o[1]=__builtin_amdgcn_mfma_f32_32x32x16_bf16(PAF(0),VFR(4),o[1],0,0,0), C0,2); VRD2(4); \
    GAPB(o[0]=__builtin_amdgcn_mfma_f32_32x32x16_bf16(PAF(1),VFR(1),o[0],0,0,0), C0,4); VRD2(1); \
    GAPB(o[1]=__builtin_amdgcn_mfma_f32_32x32x16_bf16(PAF(1),VFR(5),o[1],0,0,0), C0,6); VRD2(5); \
    GAPB(o[0]=__builtin_amdgcn_mfma_f32_32x32x16_bf16(PAF(2),VFR(2),o[0],0,0,0), C0,8); VRD2(2); \
    GAPB(o[1]=__builtin_amdgcn_mfma_f32_32x32x16_bf16(PAF(2),VFR(6),o[1],0,0,0), C0,10); VRD2(6); \
    GAPB(o[0]=__builtin_amdgcn_mfma_f32_32x32x16_bf16(PAF(3),VFR(3),o[0],0,0,0), C0,12); VRD2(3); \
    GAPB(o[1]=__builtin_amdgcn_mfma_f32_32x32x16_bf16(PAF(3),VFR(7),o[1],0,0,0), C0,14); VRD2(7); \
    GAPB(o[2]=__builtin_amdgcn_mfma_f32_32x32x16_bf16(PAF(0),VFR(0),o[2],0,0,0), C1,0); \
    KRD(GL,0); GAPB(o[3]=__builtin_amdgcn_mfma_f32_32x32x16_bf16(PAF(0),VFR(4),o[3],0,0,0), C1,2); \
    KRD(GL,1); GAPB(o[2]=__builtin_amdgcn_mfma_f32_32x32x16_bf16(PAF(1),VFR(1),o[2],0,0,0), C1,4); \
    KRD(GL,2); GAPB(o[3]=__builtin_amdgcn_mfma_f32_32x32x16_bf16(PAF(1),VFR(5),o[3],0,0,0), C1,6); \
    KRD(GL,3); GAPB(o[2]=__builtin_amdgcn_mfma_f32_32x32x16_bf16(PAF(2),VFR(2),o[2],0,0,0), C1,8); \
    GAPB(o[3]=__builtin_amdgcn_mfma_f32_32x32x16_bf16(PAF(2),VFR(6),o[3],0,0,0), C1,10); \
    GAPB(o[2]=__builtin_amdgcn_mfma_f32_32x32x16_bf16(PAF(3),VFR(3),o[2],0,0,0), C1,12); \
    GAPB(o[3]=__builtin_amdgcn_mfma_f32_32x32x16_bf16(PAF(3),VFR(7),o[3],0,0,0), C1,14); \
    }while(0)
  int t=1;
  #undef CMASK
  #define CMASK(P0,P1,t) do{}while(0)
  for(;t+5<NT;t+=2){
    STEP(pB0,pB1,pA0,pA1,t,true,true,true);     WAIT_BAR(3); ROT();
    STEP(pA0,pA1,pB0,pB1,t+1,true,true,true);   WAIT_BAR(3); ROT();
  }
  #undef CMASK
  #define CMASK(P0,P1,t) do{int jb_=(t)-(NT-4); if(jb_>=0)cmask(P0,P1,jb_,qrel,hi);}while(0)
  #define ENDW(tt) do{ if((tt)+3<NT){WAIT_BAR(3);} else if((tt)+2<NT){WAIT_BAR(2);} else {WAIT_BAR(0);} }while(0)
  for(;t+1<NT;t+=2){
    STEP(pB0,pB1,pA0,pA1,t,(t+3<NT),(t+1<NT),(t+1<NT));       ENDW(t);   ROT();
    STEP(pA0,pA1,pB0,pB1,t+1,(t+4<NT),(t+2<NT),(t+2<NT));     ENDW(t+1); ROT();
  }
  STEP(pB0,pB1,pA0,pA1,NT-1,false,false,false);
  { float sacc=pB0[0]+pB0[1]; _Pragma("unroll") for(int r=2;r<16;++r)sacc+=pB0[r]; _Pragma("unroll") for(int r=0;r<16;++r)sacc+=pB1[r]; l_reg+=sacc;
    pw0=(u32x4){PKW(pB0,0),PKW(pB0,2),PKW(pB0,4),PKW(pB0,6)};pw1=(u32x4){PKW(pB0,8),PKW(pB0,10),PKW(pB0,12),PKW(pB0,14)};pw2=(u32x4){PKW(pB1,0),PKW(pB1,2),PKW(pB1,4),PKW(pB1,6)};pw3=(u32x4){PKW(pB1,8),PKW(pB1,10),PKW(pB1,12),PKW(pB1,14)};
    SBAR(); pv(o,vb0+2*sl_cur,PAF(0),PAF(1),PAF(2),PAF(3)); }
  #undef PKW
  #undef PAF
  #undef VFR
  #undef PIN
  #undef MX3
  #undef GAPA
  #undef GAPB
  #undef EX
  #undef VRD
  #undef KRD
  #undef STEP
  #undef ENDW
  {auto rr=__builtin_amdgcn_permlane32_swap(__float_as_uint(l_reg),__float_as_uint(l_reg),false,false);l_reg=__uint_as_float(rr[0])+__uint_as_float(rr[1]);}
  if(hi==0)wsf[32+r32]=l_reg;asm volatile("s_waitcnt lgkmcnt(0)":::"memory");
  float rli[16];
  #pragma unroll
  for(int r=0;r<16;++r)rli[r]=__builtin_amdgcn_rcpf(wsf[32+crow(r,hi)]);
  bf16*Ow=O+(rowbase+q0+wid*QBLK)*OPITCH+ocol;
  { bf16*stg=(bf16*)(shm+LDS_OST)+wid*2048;
    #pragma unroll
    for(int hf=0;hf<2;++hf){
    #pragma unroll
    for(int r=0;r<16;++r){const int orow=crow(r,hi);
      #pragma unroll
      for(int d0=0;d0<2;++d0)stg[orow*64+d0*32+r32]=__float2bfloat16(o[2*hf+d0][r]*rli[r]);}
    asm volatile("s_waitcnt lgkmcnt(0)":::"memory");
    #pragma unroll
    for(int i=0;i<4;++i){const int row=i*8+(lane>>3),ch=lane&7; const u32x4 v=*(const u32x4*)(stg+row*64+ch*8); ATTN_STORE16(Ow+(long)row*OPITCH+hf*64+ch*8,v);}
    asm volatile("s_waitcnt lgkmcnt(0)":::"memory"); } }
  asm volatile("s_waitcnt lgkmcnt(0)\n\ts_barrier":::"memory");
  #undef DMA_K
  #undef DMA_V
  #undef CMASK
  #undef ROT
}
constexpr int ATTN_LDS_BYTES=LDS_BYTES;
#undef SBAR
#undef WAIT_BAR
}
#define LAS __attribute__((address_space(3)))
typedef unsigned short bf16;
typedef unsigned v4u __attribute__((ext_vector_type(4)));
typedef unsigned v2u __attribute__((ext_vector_type(2)));
typedef float f32x4 __attribute__((ext_vector_type(4)));
typedef float f32x16 __attribute__((ext_vector_type(16)));
typedef short bf16x8 __attribute__((ext_vector_type(8)));

constexpr int NWAVES = 8;
constexpr int BATCH = 2, SEQ = 16384, D = 2048, T = BATCH * SEQ, FF = 8192;
constexpr int NMOD = 6 * D;
constexpr int INW = 10256;
constexpr int NPROJ = 10752;
constexpr int PW = 7680;
constexpr int C_GQ = 0, C_GK = 512, C_GV = 1024, C_GR = 2048, C_SA = 3072, C_SB = 5120, C_LA = 7168;
constexpr float EPS = 1e-6f;
constexpr size_t MiB = 1u << 20;
constexpr size_t WS_CTL = 0, CTL_ZERO_BYTES = 1 * MiB;
constexpr size_t WS_DEC = 1 * MiB;
constexpr size_t WS_QCTR = 128 * 1024;
constexpr size_t WS_BAR = 256 * 1024;
constexpr size_t WS_WIN = 2 * MiB, WS_WP = 44 * MiB, WS_WOUT = 52 * MiB, WS_W1 = 60 * MiB, WS_W2 = 92 * MiB;
constexpr size_t WS_Q = 124 * MiB, WS_K = 188 * MiB, WS_V = 252 * MiB;
constexpr size_t WS_PROJ = 316 * MiB;
constexpr size_t WS_HID = 124 * MiB;
constexpr size_t WS_H1 = 640 * MiB;
constexpr size_t WS_MRG = 796 * MiB;
constexpr size_t WS_OGLA = 924 * MiB;
constexpr size_t WS_CS = 988 * MiB;
constexpr size_t WS_END = 990 * MiB;
constexpr int LDS_BYTES = 147456;
constexpr int REP_GLA = 1;

__device__ __forceinline__ unsigned f2bf(float f) { unsigned u = __builtin_bit_cast(unsigned, f); return (u + 0x7fffu + ((u >> 16) & 1u)) >> 16; }
__device__ __forceinline__ unsigned pk2(float lo, float hi) { return f2bf(lo) | (f2bf(hi) << 16); }
__device__ __forceinline__ float bf2f(unsigned short u) { return __uint_as_float((unsigned)u << 16); }
__device__ __forceinline__ float blo(unsigned w) { return __uint_as_float(w << 16); }
__device__ __forceinline__ float bhi(unsigned w) { return __uint_as_float(w & 0xffff0000u); }
__device__ __forceinline__ float wave_sum(float v) {
#pragma unroll
    for (int o = 1; o < 64; o <<= 1) v += __shfl_xor(v, o);
    return v;
}

#define XB_TMO      128
#define XB_XCNT(j)  (256  + 64 * (j))
#define XB_XSUB(j)  (1280 + 64 * (j))
#define XB_XGEN(j)  (2304 + 64 * (j))
#define XB_TOP      3328
#define XB_TOPGEN   3392
#define XCD_BAR_WORDS 3456
#define XB_SPIN_CAP (1u << 18)

__device__ __forceinline__ unsigned xb_ld(unsigned* p)              { return __hip_atomic_load(p, __ATOMIC_RELAXED, __HIP_MEMORY_SCOPE_AGENT); }
__device__ __forceinline__ unsigned xb_add(unsigned* p, unsigned v) { return __hip_atomic_fetch_add(p, v, __ATOMIC_RELAXED, __HIP_MEMORY_SCOPE_AGENT); }
__device__ __forceinline__ unsigned xb_xcc_id() { return (unsigned)__builtin_amdgcn_s_getreg((3 << 11) | 20) & 0xFu; }
#define XB_SPIN(cond, bar) do { unsigned _sp = 0; while (cond) { __builtin_amdgcn_s_sleep(1); \
    if ((++_sp & 255u) == 0u) { if (xb_ld(&(bar)[XB_TMO])) break; if (_sp > XB_SPIN_CAP) { atomicAdd(&(bar)[XB_TMO], 1u); break; } } } } while (0)

struct XcdBarrier {
    unsigned* bar; unsigned x;
    volatile LAS unsigned* st;
};

__device__ __forceinline__ XcdBarrier xcd_barrier_post(unsigned* bar, volatile LAS unsigned* st) {
    XcdBarrier b; b.bar = bar; b.x = xb_xcc_id(); b.st = st;
    if (threadIdx.x == 0) (void)xb_add(&bar[XB_XCNT(b.x)], 1u);
    return b;
}
__device__ __forceinline__ void xcd_barrier_complete(unsigned* bar, unsigned x, unsigned& nloc, unsigned& nx) {
    const unsigned G = gridDim.x * gridDim.y * gridDim.z;
    unsigned sum, cnt, mine, sp = 0u;
    for (;;) {
        sum = 0u; cnt = 0u; mine = 0u;
#pragma unroll
        for (unsigned j = 0; j < 16; ++j) { const unsigned c = xb_ld(&bar[XB_XCNT(j)]); sum += c; cnt += (c > 0u) ? 1u : 0u; mine = (j == x) ? c : mine; }
        if (sum == G) break;
        __builtin_amdgcn_s_sleep(1);
        if ((++sp & 255u) == 0u) { if (xb_ld(&bar[XB_TMO])) break; if (sp > XB_SPIN_CAP) { atomicAdd(&bar[XB_TMO], 1u); break; } }
    }
    nloc = mine > 0u ? mine : 1u; nx = cnt > 0u ? cnt : 1u;
}

__device__ __forceinline__ void xcd_barrier(const XcdBarrier& b) {
    asm volatile("s_waitcnt vmcnt(0)" ::: "memory");
    __syncthreads();
    if (threadIdx.x == 0) {
        unsigned* bar = b.bar;
        __builtin_amdgcn_s_waitcnt(0);
        unsigned nloc = b.st[0], nx = b.st[1];
        if (nloc == 0u) { xcd_barrier_complete(bar, b.x, nloc, nx); b.st[0] = nloc; b.st[1] = nx; }
        const unsigned old = xb_add(&bar[XB_XSUB(b.x)], 1u);
        const unsigned gen = old / nloc;
        if (old + 1u == (gen + 1u) * nloc) {
            __builtin_amdgcn_fence(__ATOMIC_RELEASE, "agent");
            asm volatile("s_waitcnt vmcnt(0)" ::: "memory");
            const unsigned og = xb_add(&bar[XB_TOP], 1u);
            const unsigned tg = og / nx;
            if (og + 1u == (tg + 1u) * nx) xb_add(&bar[XB_TOPGEN], 1u);
            else XB_SPIN(xb_ld(&bar[XB_TOPGEN]) == tg, bar);
            __builtin_amdgcn_fence(__ATOMIC_ACQUIRE, "agent");
            xb_add(&bar[XB_XGEN(b.x)], 1u);
            asm volatile("s_waitcnt vmcnt(0)" ::: "memory");
        } else {
            XB_SPIN(xb_ld(&bar[XB_XGEN(b.x)]) == gen, bar);
            __builtin_amdgcn_fence(__ATOMIC_ACQUIRE, "agent");
            asm volatile("s_waitcnt vmcnt(0)" ::: "memory");
        }
    }
    __syncthreads();
}

struct Frame {
    LAS unsigned char* lds;
    int tid, lane, wave, vcu, G;
};

namespace gla {
constexpr int QS = 272, KS = 144;
constexpr int QE_OFF = 0, KE_OFF = 17408, KDT_OFF = 34816, VT_OFF = 53248, ST_OFF = 62464, ATT_OFF = 79872, PT_OFF = 89088, DEC_OFF = 91136, END_OFF = 91648;
constexpr float L2E = 1.4426950408889634f;
__device__ __forceinline__ int crow(int r, int hi) { return (r & 3) + 8 * (r >> 2) + 4 * hi; }
__device__ __forceinline__ bf16x8 ld8(LAS unsigned char* p) { return *(LAS bf16x8*)p; }

__device__ __forceinline__ void gla_prep_item(LAS unsigned char* lds, bf16* P, float* DECB, int b, int h, int c) {
    int tid_ = threadIdx.x; asm volatile("" : "+v"(tid_));
    const int tid = tid_, col = tid & 127, part = tid >> 7;
    const size_t rbase = (size_t)b * SEQ + (size_t)c * 64;
    bf16* qp = P + (rbase + part * 16) * PW + C_GQ + h * 128 + col;
    bf16* kp = P + (rbase + part * 16) * PW + C_GK + h * 128 + col;
    const bf16* lp = P + (rbase + part * 16) * PW + C_LA + h * 128 + col;
    LAS float* PT = (LAS float*)(lds + PT_OFF);
    unsigned short cq[16], ck[16], cl[16];
#pragma unroll
    for (int r = 0; r < 16; ++r) { cq[r] = qp[(size_t)r * PW]; ck[r] = kp[(size_t)r * PW]; cl[r] = lp[(size_t)r * PW]; }
    float bb[16]; float run = 0.f;
#pragma unroll
    for (int r = 0; r < 16; ++r) { run += bf2f(cl[r]); bb[r] = run; }
    PT[part * 128 + col] = run;
    __syncthreads();
    float off = 0.f, tot = 0.f;
#pragma unroll
    for (int p = 0; p < 4; ++p) { const float x = PT[p * 128 + col]; tot += x; off += (p < part) ? x : 0.f; }
    unsigned kd[8];
#pragma unroll
    for (int r = 0; r < 16; ++r) {
        const float bv = bb[r] + off, q = bf2f(cq[r]), k = bf2f(ck[r]);
        const float qe = q * __builtin_amdgcn_exp2f(bv * L2E) * 0.08838834764831845f;
        const float ke = k * __builtin_amdgcn_exp2f(-bv * L2E);
        const float kdv = k * __builtin_amdgcn_exp2f((tot - bv) * L2E);
        qp[(size_t)r * PW] = (bf16)f2bf(qe); kp[(size_t)r * PW] = (bf16)f2bf(ke);
        if (r & 1) kd[r >> 1] |= f2bf(kdv) << 16; else kd[r >> 1] = f2bf(kdv);
    }
    bf16* kdp = P + (rbase + (col >> 1)) * PW + C_LA + h * 128 + (col & 1) * 64 + part * 16;
    *(v4u*)kdp = (v4u){kd[0], kd[1], kd[2], kd[3]}; *(v4u*)(kdp + 8) = (v4u){kd[4], kd[5], kd[6], kd[7]};
    if (part == 0) DECB[(size_t)(((b * 4 + h) * 256 + c)) * 128 + col] = __builtin_amdgcn_exp2f(tot * L2E);
    __syncthreads();
}

__device__ __forceinline__ void gla_unit(LAS unsigned char* lds, const bf16* P, const float* DECB, bf16* OG, int b, int h, int vs) {
    int tid_ = threadIdx.x; asm volatile("" : "+v"(tid_));
    const int tid = tid_, lane = tid & 63, wid = __builtin_amdgcn_readfirstlane(tid >> 6), r32 = lane & 31, hi = lane >> 5;
    const int trow = tid >> 4, tch = tid & 15;
    const size_t row0 = (size_t)b * SEQ;
    const bf16* qsrc = P + (row0 + trow) * PW + C_GQ + h * 128 + tch * 8;
    const bf16* ksrc = P + (row0 + trow) * PW + C_GK + h * 128 + tch * 8;
    const bf16* dsrc = P + (row0 + trow) * PW + C_LA + h * 128 + tch * 8;
    const bf16* vp = P + (row0 + (tid >> 3)) * PW + C_GV + h * 256 + vs * 64 + (tid & 7) * 8;
    const float* decp = DECB + (size_t)((b * 4 + h) * 256) * 128 + (tid & 31) * 4;
    f32x16 st[2];
#pragma unroll
    for (int r = 0; r < 16; ++r) { st[0][r] = 0.f; st[1][r] = 0.f; }
    if (tid < 128) *(LAS v4u*)(lds + ATT_OFF + (tid >> 2) * KS + 64 + (tid & 3) * 16) = (v4u){0u, 0u, 0u, 0u};
    v4u q0 = *(const v4u*)qsrc, q1 = *(const v4u*)(qsrc + (size_t)32 * PW), k0 = *(const v4u*)ksrc, k1 = *(const v4u*)(ksrc + (size_t)32 * PW);
    v4u d0 = *(const v4u*)dsrc, d1 = *(const v4u*)(dsrc + (size_t)32 * PW), cv = *(const v4u*)vp;
    f32x4 dc = *(const f32x4*)decp;
    constexpr int NC = SEQ / 64;
    for (int c = 0; c < NC; ++c) {
        *(LAS v4u*)(lds + QE_OFF + trow * QS + tch * 16) = q0; *(LAS v4u*)(lds + QE_OFF + (trow + 32) * QS + tch * 16) = q1;
        *(LAS v4u*)(lds + KE_OFF + trow * QS + tch * 16) = k0; *(LAS v4u*)(lds + KE_OFF + (trow + 32) * QS + tch * 16) = k1;
        { const int kk = 2 * trow + (tch >> 3), j0 = (tch & 7) * 8;
          *(LAS v4u*)(lds + KDT_OFF + kk * KS + j0 * 2) = d0; *(LAS v4u*)(lds + KDT_OFF + (kk + 64) * KS + j0 * 2) = d1; }
        if (tid < 32) *(LAS f32x4*)(lds + DEC_OFF + tid * 16) = dc;
        {
            const int j = tid >> 3, v0 = (tid & 7) * 8;
#pragma unroll
            for (int e = 0; e < 4; ++e) { const unsigned w = cv[e];
                *(LAS unsigned short*)(lds + VT_OFF + (v0 + 2 * e) * KS + j * 2) = (unsigned short)(w & 0xffffu);
                *(LAS unsigned short*)(lds + VT_OFF + (v0 + 2 * e + 1) * KS + j * 2) = (unsigned short)(w >> 16); }
        }
        if (wid >= 4) { const int kblk = wid - 4;
#pragma unroll
            for (int vb = 0; vb < 2; ++vb)
#pragma unroll
            for (int g = 0; g < 4; ++g)
                *(LAS v2u*)(lds + ST_OFF + (vb * 32 + r32) * QS + (kblk * 32 + 8 * g + 4 * hi) * 2) = (v2u){pk2(st[vb][4 * g], st[vb][4 * g + 1]), pk2(st[vb][4 * g + 2], st[vb][4 * g + 3])};
        }
        {
            const size_t nx = (size_t)((c + 1 < NC) ? (c + 1) : c) * 64 * PW;
            q0 = *(const v4u*)(qsrc + nx); q1 = *(const v4u*)(qsrc + nx + (size_t)32 * PW); k0 = *(const v4u*)(ksrc + nx); k1 = *(const v4u*)(ksrc + nx + (size_t)32 * PW);
            d0 = *(const v4u*)(dsrc + nx); d1 = *(const v4u*)(dsrc + nx + (size_t)32 * PW); cv = *(const v4u*)(vp + nx);
            dc = *(const f32x4*)(decp + (size_t)((c + 1 < NC) ? (c + 1) : c) * 128);
        }
        asm volatile("s_waitcnt lgkmcnt(0)\n\ts_barrier" ::: "memory");
        if (wid < 3) {
            const int jb = (wid == 2) ? 1 : 0, ib = (wid >= 1) ? 1 : 0;
            f32x16 a;
#pragma unroll
            for (int r = 0; r < 16; ++r) a[r] = 0.f;
#pragma unroll
            for (int s = 0; s < 8; ++s) {
                const bf16x8 ka = ld8(lds + KE_OFF + (jb * 32 + r32) * QS + (16 * s + 8 * hi) * 2);
                const bf16x8 qb = ld8(lds + QE_OFF + (ib * 32 + r32) * QS + (16 * s + 8 * hi) * 2);
                a = __builtin_amdgcn_mfma_f32_32x32x16_bf16(ka, qb, a, 0, 0, 0);
            }
            const int ig = ib * 32 + r32;
#pragma unroll
            for (int g = 0; g < 4; ++g) { const int j0 = jb * 32 + 8 * g + 4 * hi;
                const float x0 = (j0 + 0 <= ig) ? a[4 * g + 0] : 0.f, x1 = (j0 + 1 <= ig) ? a[4 * g + 1] : 0.f, x2 = (j0 + 2 <= ig) ? a[4 * g + 2] : 0.f, x3 = (j0 + 3 <= ig) ? a[4 * g + 3] : 0.f;
                *(LAS v2u*)(lds + ATT_OFF + ig * KS + j0 * 2) = (v2u){pk2(x0, x1), pk2(x2, x3)}; }
        } else if (wid >= 4) {
            const int kblk = wid - 4;
#pragma unroll
            for (int g = 0; g < 4; ++g) { const f32x4 d = *(LAS f32x4*)(lds + DEC_OFF + (kblk * 32 + 8 * g + 4 * hi) * 4);
#pragma unroll
                for (int vb = 0; vb < 2; ++vb) { st[vb][4 * g] *= d[0]; st[vb][4 * g + 1] *= d[1]; st[vb][4 * g + 2] *= d[2]; st[vb][4 * g + 3] *= d[3]; } }
#pragma unroll
            for (int s = 0; s < 4; ++s) {
                const bf16x8 ka = ld8(lds + KDT_OFF + (kblk * 32 + r32) * KS + (16 * s + 8 * hi) * 2);
                const bf16x8 v0 = ld8(lds + VT_OFF + r32 * KS + (16 * s + 8 * hi) * 2);
                const bf16x8 v1 = ld8(lds + VT_OFF + (32 + r32) * KS + (16 * s + 8 * hi) * 2);
                st[0] = __builtin_amdgcn_mfma_f32_32x32x16_bf16(ka, v0, st[0], 0, 0, 0);
                st[1] = __builtin_amdgcn_mfma_f32_32x32x16_bf16(ka, v1, st[1], 0, 0, 0);
            }
        }
        asm volatile("s_waitcnt lgkmcnt(0)\n\ts_barrier" ::: "memory");
        if (wid < 4) {
            const int ib = wid & 1, vb = wid >> 1;
            f32x16 o;
#pragma unroll
            for (int r = 0; r < 16; ++r) o[r] = 0.f;
#pragma unroll
            for (int s = 0; s < 8; ++s) {
                const bf16x8 qa = ld8(lds + QE_OFF + (ib * 32 + r32) * QS + (16 * s + 8 * hi) * 2);
                const bf16x8 sb = ld8(lds + ST_OFF + (vb * 32 + r32) * QS + (16 * s + 8 * hi) * 2);
                o = __builtin_amdgcn_mfma_f32_32x32x16_bf16(qa, sb, o, 0, 0, 0);
            }
#pragma unroll
            for (int s = 0; s < 4; ++s) {
                const bf16x8 aa = ld8(lds + ATT_OFF + (ib * 32 + r32) * KS + (16 * s + 8 * hi) * 2);
                const bf16x8 vv = ld8(lds + VT_OFF + (vb * 32 + r32) * KS + (16 * s + 8 * hi) * 2);
                o = __builtin_amdgcn_mfma_f32_32x32x16_bf16(aa, vv, o, 0, 0, 0);
            }
            bf16* op = OG + (row0 + (size_t)c * 64 + ib * 32) * 1024 + h * 256 + vs * 64 + vb * 32 + r32;
#pragma unroll
            for (int r = 0; r < 16; ++r) op[(size_t)crow(r, hi) * 1024] = (bf16)f2bf(o[r]);
        }
        asm volatile("s_waitcnt lgkmcnt(0)\n\ts_barrier" ::: "memory");
    }
}
}

__device__ __forceinline__ void transpose_item(const float* W, int ldw, int src_c0, bf16* WT, int ldt, int dst_r0, int dst_k0, int nblk, LAS float* scr, int item, int lane) {
    const int kb = item / nblk, nb = item % nblk, k0 = 64 * kb, n0 = 32 * nb;
    float tv[32];
#pragma unroll
    for (int i = 0; i < 32; ++i) { const int kk = 2 * i + (lane >> 5); tv[i] = W[(size_t)(k0 + kk) * ldw + src_c0 + n0 + (lane & 31)]; }
#pragma unroll
    for (int i = 0; i < 32; ++i) { const int kk = 2 * i + (lane >> 5); scr[kk * 33 + (lane & 31)] = tv[i]; }
    asm volatile("s_waitcnt lgkmcnt(0)" ::: "memory");
    const int c = lane & 7;
#pragma unroll
    for (int j = 0; j < 4; ++j) { const int n = (lane >> 3) + 8 * j; const LAS float* s = scr + (8 * c) * 33 + n;
        v4u o; o.x = pk2(s[0 * 33], s[1 * 33]); o.y = pk2(s[2 * 33], s[3 * 33]); o.z = pk2(s[4 * 33], s[5 * 33]); o.w = pk2(s[6 * 33], s[7 * 33]);
        *(v4u*)(WT + (size_t)(dst_r0 + n0 + n) * ldt + dst_k0 + k0 + 8 * c) = o; }
    asm volatile("s_waitcnt lgkmcnt(0)" ::: "memory");
}

struct Args {
    const float* x; const float* c; const int* pos; const float* w_ada; const float* b_ada; const float* norm1_g; const float* w_in;
    const float* qn_g; const float* kn_g; const float* lq1; const float* lk1; const float* lq2; const float* lk2; const float* subln_g;
    const float* gate_up; const float* gate_bias; const float* gout_g; const float* w_pa; const float* w_pb; const float* w_out; const float* norm2_g;
    const float* w1; const float* w2; float* out; unsigned char* ws; int ph_lo, ph_hi;
};

__device__ __forceinline__ void p0_prologue(const Frame& F, const Args& a) {
    unsigned char* ws = a.ws;
    bf16* Wt_in = (bf16*)(ws + WS_WIN); bf16* Wt_p = (bf16*)(ws + WS_WP); bf16* Wt_out = (bf16*)(ws + WS_WOUT); bf16* Wt_1 = (bf16*)(ws + WS_W1); bf16* Wt_2 = (bf16*)(ws + WS_W2);
    float* modacc = (float*)(ws + WS_CTL);
    {
        LAS float* sc = (LAS float*)(F.lds + 140000);
        for (int it = blockIdx.x; it < 32 * 6; it += F.G) {
            const int kc = it / 6, jc = it % 6;
            __syncthreads();
            if (F.tid < 128) { const int bb = F.tid >> 6, kk = F.tid & 63; const float cv = a.c[bb * D + kc * 64 + kk]; sc[F.tid] = cv / (1.0f + __expf(-cv)); }
            __syncthreads();
            const int j = jc * 2048 + F.tid * 4;
            f32x4 a0 = (f32x4){0.f, 0.f, 0.f, 0.f}, a1 = (f32x4){0.f, 0.f, 0.f, 0.f};
            const float* wp = a.w_ada + (size_t)(kc * 64) * NMOD + j;
#pragma unroll 8
            for (int kk = 0; kk < 64; ++kk) { const f32x4 w = *(const f32x4*)(wp + (size_t)kk * NMOD); a0 += w * sc[kk]; a1 += w * sc[64 + kk]; }
#pragma unroll
            for (int e = 0; e < 4; ++e) { unsafeAtomicAdd(modacc + j + e, a0[e]); unsafeAtomicAdd(modacc + NMOD + j + e, a1[e]); }
        }
        __syncthreads();
    }
    LAS float* scr = (LAS float*)(F.lds + F.wave * 16384);
    const int gw = F.vcu * NWAVES + F.wave, NGW = F.G * NWAVES;
    constexpr int I_A = 32 * 192, I_B = 32 * 128, I_C = 16 * 64, I_D = 16 * 64, I_E = 32 * 64, I_F = 32 * 256, I_G = 128 * 64;
    constexpr int NITEMS = I_A + I_B + I_C + I_D + I_E + I_F + I_G;
    for (int it = gw; it < NITEMS; it += NGW) {
        int r = it;
        if (r < I_A) { transpose_item(a.w_in, INW, 0, Wt_in, D, 0, 0, 192, scr, r, F.lane); continue; } r -= I_A;
        if (r < I_B) { transpose_item(a.w_in, INW, 6160, Wt_in, D, 6144, 0, 128, scr, r, F.lane); continue; } r -= I_B;
        if (r < I_C) { transpose_item(a.w_pa, D, 0, Wt_p, D, 0, 0, 64, scr, r, F.lane); continue; } r -= I_C;
        if (r < I_D) { transpose_item(a.w_pb, D, 0, Wt_p, D, 0, 1024, 64, scr, r, F.lane); continue; } r -= I_D;
        if (r < I_E) { transpose_item(a.w_out, D, 0, Wt_out, D, 0, 0, 64, scr, r, F.lane); continue; } r -= I_E;
        if (r < I_F) { transpose_item(a.w1, FF, 0, Wt_1, D, 0, 0, 256, scr, r, F.lane); continue; } r -= I_F;
        transpose_item(a.w2, D, 0, Wt_2, FF, 0, 0, 64, scr, r, F.lane);
    }
    for (int idx = blockIdx.x * 512 + F.tid; idx < 512 * 256; idx += F.G * 512) {
        const int n = idx & 511, kc = idx >> 9;
        float up[16];
#pragma unroll
        for (int r = 0; r < 16; ++r) up[r] = a.gate_up[r * 512 + n];
        float o[8];
#pragma unroll
        for (int e = 0; e < 8; ++e) { const float* wr = a.w_in + (size_t)(kc * 8 + e) * INW + 6144; float s = 0.f;
#pragma unroll
            for (int r = 0; r < 16; ++r) s += wr[r] * up[r];
            o[e] = s; }
        *(v4u*)(Wt_in + (size_t)(10240 + n) * D + kc * 8) = (v4u){pk2(o[0], o[1]), pk2(o[2], o[3]), pk2(o[4], o[5]), pk2(o[6], o[7])};
    }
}

template <bool SRC16> __device__ __forceinline__ void modnorm_phase(const Frame& F, const Args& a, const void* __restrict__ srcv, bf16* __restrict__ dst, const float* g, int shift_off, int scale_off) {
    const float* __restrict__ src = (const float*)srcv; const bf16* __restrict__ src16 = (const bf16*)srcv;
    const float* modacc = (const float*)(a.ws + WS_CTL);
    const int gw = F.vcu * NWAVES + F.wave, NGW = F.G * NWAVES;
#pragma unroll 1
    for (int b = 0; b < BATCH; ++b) {
        f32x4 A[8], B[8];
#pragma unroll
        for (int j = 0; j < 8; ++j) { const int d = (F.lane + 64 * j) * 4;
            const f32x4 gg = *(const f32x4*)(g + d);
            const f32x4 sc = *(const f32x4*)(modacc + b * NMOD + scale_off + d) + *(const f32x4*)(a.b_ada + scale_off + d);
            const f32x4 sh = *(const f32x4*)(modacc + b * NMOD + shift_off + d) + *(const f32x4*)(a.b_ada + shift_off + d);
            A[j] = gg * (sc + 1.0f); B[j] = sh; }
        const int mend = (b + 1) * SEQ;
#pragma unroll 1
        for (int m = b * SEQ + gw; m < mend; m += 2 * NGW) {
            const int m1 = (m + NGW < mend) ? m + NGW : m;
            f32x4 v[8], w[8]; float s0 = 0.f, s1 = 0.f;
            if constexpr (SRC16) {
                const v2u* x0 = (const v2u*)(src16 + (size_t)m * D) + F.lane; const v2u* x1 = (const v2u*)(src16 + (size_t)m1 * D) + F.lane;
                v2u rv[8], rw[8];
#pragma unroll
                for (int j = 0; j < 8; ++j) { rv[j] = x0[64 * j]; rw[j] = x1[64 * j]; }
#pragma unroll
                for (int j = 0; j < 8; ++j) { v[j] = (f32x4){blo(rv[j].x), bhi(rv[j].x), blo(rv[j].y), bhi(rv[j].y)}; w[j] = (f32x4){blo(rw[j].x), bhi(rw[j].x), blo(rw[j].y), bhi(rw[j].y)}; }
            } else {
                const f32x4* x0 = (const f32x4*)(src + (size_t)m * D) + F.lane; const f32x4* x1 = (const f32x4*)(src + (size_t)m1 * D) + F.lane;
#pragma unroll
                for (int j = 0; j < 8; ++j) { v[j] = x0[64 * j]; w[j] = x1[64 * j]; }
            }
#pragma unroll
            for (int j = 0; j < 8; ++j) { s0 += (v[j].x * v[j].x + v[j].y * v[j].y) + (v[j].z * v[j].z + v[j].w * v[j].w); s1 += (w[j].x * w[j].x + w[j].y * w[j].y) + (w[j].z * w[j].z + w[j].w * w[j].w); }
            const float r0 = 1.0f / sqrtf(wave_sum(s0) * (1.0f / D) + EPS), r1 = 1.0f / sqrtf(wave_sum(s1) * (1.0f / D) + EPS);
            v2u* o0 = (v2u*)(dst + (size_t)m * D) + F.lane; v2u* o1 = (v2u*)(dst + (size_t)m1 * D) + F.lane;
#pragma unroll
            for (int j = 0; j < 8; ++j) { const f32x4 y = v[j] * r0 * A[j] + B[j]; o0[64 * j] = (v2u){pk2(y.x, y.y), pk2(y.z, y.w)}; if (j & 1) asm volatile("" ::: "memory"); }
#pragma unroll
            for (int j = 0; j < 8; ++j) { const f32x4 y = w[j] * r1 * A[j] + B[j]; o1[64 * j] = (v2u){pk2(y.x, y.y), pk2(y.z, y.w)}; if (j & 1) asm volatile("" ::: "memory"); }
        }
    }
}

__device__ __forceinline__ void rope_table(const Frame& F, const Args& a) {
    float* CS = (float*)(a.ws + WS_CS);
    const double invf[8] = {1.0, 0.19392274474868576, 0.03760603093086393, 0.007292664737217109, 0.001414213562373095, 0.0002742481756762073, 5.318295896944988e-05, 1.031338537721246e-05};
    for (int idx = blockIdx.x * 512 + F.tid; idx < T * 8; idx += F.G * 512) {
        const int m = idx >> 3, i = idx & 7;
        double f = invf[0];
#pragma unroll
        for (int k = 1; k < 8; ++k) f = (i == k) ? invf[k] : f;
        double rev = (double)a.pos[m] * f * 0.15915494309189535; rev -= __builtin_floor(rev);
        CS[m * 16 + i] = __builtin_amdgcn_cosf((float)rev); CS[m * 16 + 8 + i] = __builtin_amdgcn_sinf((float)rev);
    }
}

__device__ __forceinline__ void combine_phase(const Frame& F, const Args& a, const bf16* __restrict__ OT, bf16* __restrict__ Y) {
    const bf16* __restrict__ P = (const bf16*)(a.ws + WS_PROJ); const bf16* __restrict__ OG = (const bf16*)(a.ws + WS_OGLA);
    const int gw = F.vcu * NWAVES + F.wave, NGW = F.G * NWAVES;
    const float d1 = wave_sum(a.lq1[F.lane] * a.lk1[F.lane]), d2 = wave_sum(a.lq2[F.lane] * a.lk2[F.lane]);
    const float lam = __expf(d1) - __expf(d2) + 0.2f;
    const int l16 = F.lane & 15, h4 = F.lane >> 4;
    float sg[8];
#pragma unroll
    for (int e = 0; e < 8; ++e) sg[e] = a.subln_g[l16 * 8 + e] * 0.8f;
    float og[16];
#pragma unroll
    for (int e = 0; e < 16; ++e) og[e] = a.gout_g[l16 * 16 + e];
    for (int m = gw; m < T; m += NGW) {
        const bf16* ot = OT + (size_t)m * D; bf16* y = Y + (size_t)m * D;
        const int vh = l16 >> 3, d = (l16 & 7) * 8;
        v4u a0[2], a1[2];
#pragma unroll
        for (int pass = 0; pass < 2; ++pass) { const int h = pass * 4 + h4; a0[pass] = *(const v4u*)(ot + ((h * 2 + 0) * 2 + vh) * 64 + d); a1[pass] = *(const v4u*)(ot + ((h * 2 + 1) * 2 + vh) * 64 + d); }
        const bf16* gp = OG + (size_t)m * 1024 + h4 * 256 + l16 * 16; const bf16* rp = P + (size_t)m * PW + C_GR + h4 * 256 + l16 * 16;
        const v4u w0 = *(const v4u*)gp, w1 = *(const v4u*)(gp + 8), r0 = *(const v4u*)rp, r1 = *(const v4u*)(rp + 8);
#pragma unroll
        for (int pass = 0; pass < 2; ++pass) {
            const int h = pass * 4 + h4;
            const v4u u0 = a0[pass], u1 = a1[pass];
            float o[8] = {blo(u0.x) - lam * blo(u1.x), bhi(u0.x) - lam * bhi(u1.x), blo(u0.y) - lam * blo(u1.y), bhi(u0.y) - lam * bhi(u1.y),
                          blo(u0.z) - lam * blo(u1.z), bhi(u0.z) - lam * bhi(u1.z), blo(u0.w) - lam * blo(u1.w), bhi(u0.w) - lam * bhi(u1.w)};
            float ss = 0.f;
#pragma unroll
            for (int e = 0; e < 8; ++e) ss += o[e] * o[e];
            ss += __shfl_xor(ss, 1); ss += __shfl_xor(ss, 2); ss += __shfl_xor(ss, 4); ss += __shfl_xor(ss, 8);
            const float rstd = 1.0f / sqrtf(ss * (1.0f / 128.0f) + EPS);
#pragma unroll
            for (int e = 0; e < 8; ++e) o[e] = o[e] * rstd * sg[e];
            *(v4u*)(y + h * 128 + l16 * 8) = (v4u){pk2(o[0], o[1]), pk2(o[2], o[3]), pk2(o[4], o[5]), pk2(o[6], o[7])};
        }
        {
            float o[16] = {blo(w0.x), bhi(w0.x), blo(w0.y), bhi(w0.y), blo(w0.z), bhi(w0.z), blo(w0.w), bhi(w0.w), blo(w1.x), bhi(w1.x), blo(w1.y), bhi(w1.y), blo(w1.z), bhi(w1.z), blo(w1.w), bhi(w1.w)};
            const float rr[16] = {blo(r0.x), bhi(r0.x), blo(r0.y), bhi(r0.y), blo(r0.z), bhi(r0.z), blo(r0.w), bhi(r0.w), blo(r1.x), bhi(r1.x), blo(r1.y), bhi(r1.y), blo(r1.z), bhi(r1.z), blo(r1.w), bhi(r1.w)};
            float ss = 0.f;
#pragma unroll
            for (int e = 0; e < 16; ++e) ss += o[e] * o[e];
            ss += __shfl_xor(ss, 1); ss += __shfl_xor(ss, 2); ss += __shfl_xor(ss, 4); ss += __shfl_xor(ss, 8);
            const float rstd = 1.0f / sqrtf(ss * (1.0f / 256.0f) + EPS);
#pragma unroll
            for (int e = 0; e < 16; ++e) o[e] = o[e] * rstd * og[e] * rr[e];
            bf16* yp = y + 1024 + h4 * 256 + l16 * 16;
            *(v4u*)yp = (v4u){pk2(o[0], o[1]), pk2(o[2], o[3]), pk2(o[4], o[5]), pk2(o[6], o[7])};
            *(v4u*)(yp + 8) = (v4u){pk2(o[8], o[9]), pk2(o[10], o[11]), pk2(o[12], o[13]), pk2(o[14], o[15])};
        }
    }
}

__global__ void __launch_bounds__(NWAVES * 64, 2) mega_fwd(Args args) {
    extern __shared__ __attribute__((aligned(16))) unsigned char lds[];
    cg::grid_group grid = cg::this_grid();
    Frame F;
    F.lds = (LAS unsigned char*)lds;
    F.tid = threadIdx.x; F.lane = F.tid & 63; F.wave = __builtin_amdgcn_readfirstlane(F.tid >> 6);
    F.G = gridDim.x; { const int bx = blockIdx.x; F.vcu = (F.G % 8 == 0) ? (bx % 8) * (F.G / 8) + bx / 8 : bx; }
    unsigned char* ws = args.ws;
    bf16* Wt_in = (bf16*)(ws + WS_WIN); bf16* Wt_p = (bf16*)(ws + WS_WP); bf16* Wt_out = (bf16*)(ws + WS_WOUT); bf16* Wt_1 = (bf16*)(ws + WS_W1); bf16* Wt_2 = (bf16*)(ws + WS_W2);
    bf16* PROJ = (bf16*)(ws + WS_PROJ); bf16* HID = (bf16*)(ws + WS_HID); bf16* QB = (bf16*)(ws + WS_Q); bf16* KB = (bf16*)(ws + WS_K); bf16* VB = (bf16*)(ws + WS_V); bf16* MRG = (bf16*)(ws + WS_MRG); bf16* H1 = (bf16*)(ws + WS_H1); bf16* OGLA = (bf16*)(ws + WS_OGLA);
    bf16* U = (bf16*)args.out; bf16* OT = (bf16*)args.out; bf16* Y = (bf16*)((unsigned char*)args.out + 128 * MiB);
    const float* modacc = (const float*)(ws + WS_CTL);
    const int lo = args.ph_lo, hi = args.ph_hi;
#define IN(k) (lo <= (k) && (k) < hi)
    if (F.tid < 4) ((LAS unsigned*)(F.lds + 141024))[F.tid] = 0u;
    __syncthreads();
    const XcdBarrier xbar = xcd_barrier_post((unsigned*)(ws + WS_BAR), (volatile LAS unsigned*)(F.lds + 141024));
#define SEAM(k) do { if (IN(k) && IN((k) + 1)) { if ((k) == 0) grid.sync(); else xcd_barrier(xbar); } } while (0)

    if (((PH_MASK >> 0) & 1) && IN(0)) { p0_prologue(F, args); } SEAM(0);
    if (((PH_MASK >> 1) & 1) && IN(1)) { modnorm_phase<false>(F, args, args.x, U, args.norm1_g, 0, D); rope_table(F, args); } SEAM(1);
    if (((PH_MASK >> 2) & 1) && IN(2)) {
        pg8::Gemm g{U, Wt_in, T, NPROJ, D}; pg8::StaticOrder S; S.init(T, NPROJ, F.G, (int)blockIdx.x);
        pg8::EpiProj E{QB, PROJ, args.gate_bias, (const float*)(ws + WS_CS), args.qn_g, args.kn_g, (LAS float*)(F.lds + 131072)};
        pg8::gemm_phase<pg8::EpiProj, pg8::StaticOrder, true, true>(F.lds, g, S, E);
    } SEAM(2);
    if (((PH_MASK >> 3) & 1) && IN(3)) {
        for (int it = F.vcu; it < 2048; it += F.G) gla::gla_prep_item(F.lds, PROJ, (float*)(ws + WS_DEC), it >> 10, (it >> 8) & 3, it & 255);
    } SEAM(3);
    if (((PH_MASK >> 4) & 1) && IN(4)) {
#ifndef NO_GLA
        if ((F.vcu & 7) == 0) for (int u = F.vcu >> 3; u < 32; u += (F.G + 7) >> 3) gla::gla_unit(F.lds, PROJ, (const float*)(ws + WS_DEC), OGLA, u >> 4, (u >> 2) & 3, u & 3);
#endif
#ifndef NO_ATTN
        {
            unsigned* qctr = (unsigned*)(ws + WS_QCTR);
            volatile LAS int* sh = (volatile LAS int*)(F.lds + 140000);
            int q = (int)(__builtin_amdgcn_s_getreg((3 << 11) | 20) & 0x7u), tries = 0;
            for (;;) {
                __syncthreads();
                if (F.tid == 0) { int it = -1;
                    while (tries < 8) { const unsigned v = __hip_atomic_fetch_add(qctr + q * 64, 1u, __ATOMIC_RELAXED, __HIP_MEMORY_SCOPE_AGENT); if (v < 256u) { it = q * 256 + (int)v; break; } q = (q + 1) & 7; ++tries; }
                    sh[0] = it; }
                __syncthreads();
                const int it = sh[0];
                if (it < 0) break;
                const int k = it & 255, bhc = (it >> 8) * 4 + (k & 3), qb = 63 - (k >> 2);
                const int c = bhc & 1, h = (bhc >> 1) & 7, b = bhc >> 4;
                attn_body::attn_unit<8>(b, (h * 2 + c) * 64, (h * 2 + c) * 64, h * 128, (h * 2 + c) * 128, qb, (const attn_body::bf16*)QB, (const attn_body::bf16*)KB, (const attn_body::bf16*)VB, (attn_body::bf16*)OT, (char*)lds);
            }
        }
#endif
    } SEAM(4);
    if (((PH_MASK >> 5) & 1) && IN(5)) { combine_phase(F, args, OT, Y); } SEAM(5);
    if (((PH_MASK >> 6) & 1) && IN(6)) {
        pg8::Gemm g{Y, Wt_p, T, D, D}; pg8::StaticOrder S; S.init(T, D, F.G, (int)blockIdx.x);
        pg8::EpiMerge E{MRG, D, PROJ, PW};
        pg8::gemm_phase<pg8::EpiMerge, pg8::StaticOrder, true, true>(F.lds, g, S, E);
    } SEAM(6);
    if (((PH_MASK >> 7) & 1) && IN(7)) {
        pg8::Gemm g{MRG, Wt_out, T, D, D}; pg8::StaticOrder S; S.init(T, D, F.G, (int)blockIdx.x);
        pg8::EpiRes<false, true> E{args.x, H1, D, modacc, args.b_ada, 2 * D, SEQ};
        pg8::gemm_phase<pg8::EpiRes<false, true>, pg8::StaticOrder, true, true>(F.lds, g, S, E);
    } SEAM(7);
    if (((PH_MASK >> 8) & 1) && IN(8)) { modnorm_phase<true>(F, args, H1, MRG, args.norm2_g, 3 * D, 4 * D); } SEAM(8);
    if (((PH_MASK >> 9) & 1) && IN(9)) {
        pg8::Gemm g{MRG, Wt_1, T, FF, D}; pg8::StaticOrder S; S.init(T, FF, F.G, (int)blockIdx.x);
        pg8::EpiRelu2 E{HID, FF};
        pg8::gemm_phase<pg8::EpiRelu2, pg8::StaticOrder, true, true>(F.lds, g, S, E);
    } SEAM(9);
    if (((PH_MASK >> 10) & 1) && IN(10)) {
        pg8::Gemm g{HID, Wt_2, T, D, FF}; pg8::StaticOrder S; S.init(T, D, F.G, (int)blockIdx.x);
        pg8::EpiRes<true, false> E{H1, args.out, D, modacc, args.b_ada, 5 * D, SEQ};
        pg8::gemm_phase<pg8::EpiRes<true, false>, pg8::StaticOrder, true, true>(F.lds, g, S, E);
    }
#undef IN
#undef SEAM
}

extern "C" void kernel_launch(void* const* d_in, const int* in_sizes, int n_in, void* d_out, int out_size, void* d_ws, size_t ws_size, hipStream_t stream) {
    static int grid = 0;
    if (grid == 0) {
        if (n_in != 23 || out_size != T * D || ws_size < WS_END) { fprintf(stderr, "kernel_launch: unexpected shapes (n_in %d out %d ws %zu)\n", n_in, out_size, ws_size); grid = -1; return; }
        int dev = 0, cus = 0, per_cu = 0;
        if (hipGetDevice(&dev) != hipSuccess || hipDeviceGetAttribute(&cus, hipDeviceAttributeMultiprocessorCount, dev) != hipSuccess) { grid = -1; return; }
        if (hipFuncSetAttribute((const void*)mega_fwd, hipFuncAttributeMaxDynamicSharedMemorySize, LDS_BYTES) != hipSuccess) { fprintf(stderr, "hipFuncSetAttribute failed\n"); grid = -1; return; }
        if (hipOccupancyMaxActiveBlocksPerMultiprocessor(&per_cu, (const void*)mega_fwd, NWAVES * 64, LDS_BYTES) != hipSuccess || per_cu < 1) per_cu = 1;
        (void)hipGetLastError();
        grid = cus * per_cu;
    }
    if (grid < 0) return;
    if (hipMemsetAsync((char*)d_ws + WS_CTL, 0, CTL_ZERO_BYTES, stream) != hipSuccess) { fprintf(stderr, "memset failed\n"); return; }
    Args a{};
    a.x = (const float*)d_in[0]; a.c = (const float*)d_in[1]; a.pos = (const int*)d_in[2]; a.w_ada = (const float*)d_in[3]; a.b_ada = (const float*)d_in[4]; a.norm1_g = (const float*)d_in[5];
    a.w_in = (const float*)d_in[6]; a.qn_g = (const float*)d_in[7]; a.kn_g = (const float*)d_in[8]; a.lq1 = (const float*)d_in[9]; a.lk1 = (const float*)d_in[10]; a.lq2 = (const float*)d_in[11];
    a.lk2 = (const float*)d_in[12]; a.subln_g = (const float*)d_in[13]; a.gate_up = (const float*)d_in[14]; a.gate_bias = (const float*)d_in[15]; a.gout_g = (const float*)d_in[16];
    a.w_pa = (const float*)d_in[17]; a.w_pb = (const float*)d_in[18]; a.w_out = (const float*)d_in[19]; a.norm2_g = (const float*)d_in[20]; a.w1 = (const float*)d_in[21]; a.w2 = (const float*)d_in[22];
    a.out = (float*)d_out; a.ws = (unsigned char*)d_ws; a.ph_lo = 0; a.ph_hi = 11;
    void* kargs[] = {&a};
    const hipError_t e = hipLaunchCooperativeKernel((const void*)mega_fwd, dim3(grid), dim3(NWAVES * 64), kargs, LDS_BYTES, stream);
    if (e != hipSuccess) fprintf(stderr, "cooperative launch failed: %s (grid %d)\n", hipGetErrorString(e), grid);
}
```

```cpp
#include <hip/hip_runtime.h>
#include <hip/hip_cooperative_groups.h>
#include <cstdio>
#include <cstdint>
namespace cg = cooperative_groups;
#ifndef PH_MASK
#define PH_MASK 0x7ff
#endif
namespace pg8 {
#define PG8_LAS __attribute__((address_space(3)))
typedef unsigned short bf16_t;
typedef short bf16x8 __attribute__((ext_vector_type(8)));
typedef float f32x4 __attribute__((ext_vector_type(4)));
typedef unsigned u32x4 __attribute__((ext_vector_type(4)));
constexpr int BM = 256, BK = 64, HALF = 128, HTB = HALF * BK * 2  , STAGE_BYTES = 8 * HTB, NXCD = 8, WGM = 8;

__host__ __device__ __forceinline__ int lds_byte(int r, int c) { const int st = (r >> 4) * 2 + (c >> 5), rr = r & 15, cc = c & 31, ob = rr * 64 + cc * 2; return st * 1024 + (ob ^ (((ob >> 9) & 1) << 5)); }
__host__ __device__ __forceinline__ void stage_rc(int b, int& R, int& C) { const int st = b / 1024, sb = b % 1024, swz = sb ^ (((sb >> 9) & 1) << 5); R = (st >> 1) * 16 + swz / 64; C = (st & 1) * 32 + (swz % 64) / 2; }
__host__ __device__ __forceinline__ int perm32(int rho) { const int n = rho >> 4, i = rho & 15; return 8 * (i >> 2) + 4 * n + (i & 3); }

struct Unit { int pm, pn; };
struct Gemm { const bf16_t* A; const bf16_t* Bt; int M, N, K; };

struct StaticOrder {
    int nM, nN, nwg, G, c;
    __host__ __device__ void init(int M, int N, int G_, int c_) { nM = M / BM; nN = N / BM; nwg = nM * nN; G = G_; c = c_; }
    __host__ __device__ bool next(int i, Unit& u) const {
        const long L = (long)i * G + c; if (L >= nwg) return false;
        int wgid = (int)L; { const int q = nwg / NXCD, r = nwg % NXCD, xcd = wgid % NXCD, off = wgid / NXCD; wgid = (xcd < r ? xcd * (q + 1) : r * (q + 1) + (xcd - r) * q) + off; }
        const int nig = WGM * nN, gid = wgid / nig, fm = gid * WGM, gsz = (nM - fm) < WGM ? (nM - fm) : WGM;
        u.pm = fm + ((wgid % nig) % gsz); u.pn = (wgid % nig) / gsz; return true;
    }
    __device__ __forceinline__ void a_ready(const Unit&) const {}
    __device__ __forceinline__ void done(const Unit&) const {}
};

__device__ __forceinline__ unsigned cvt_pk_bf16(float lo, float hi) { unsigned r; asm volatile("v_cvt_pk_bf16_f32 %0, %1, %2" : "=v"(r) : "v"(lo), "v"(hi)); return r; }
typedef float f32x2 __attribute__((ext_vector_type(2)));
__device__ __forceinline__ f32x2 gelu_pk(f32x2 v) {
    const f32x2 av = __builtin_elementwise_abs(v), d = av * 0.2316418882f + 1.0f;
    f32x2 t; t.x = __builtin_amdgcn_rcpf(d.x); t.y = __builtin_amdgcn_rcpf(d.y);
    f32x2 q = t * 0.5307027145f + (-0.7265760135f); q = q * t + 0.7107068705f; q = q * t + (-0.142248368f); q = q * t + 0.127414796f; q = q * t;
    const f32x2 s = (v * v) * (-0.72134752044f);
    f32x2 e; e.x = __builtin_amdgcn_exp2f(s.x); e.y = __builtin_amdgcn_exp2f(s.y);
    const f32x2 m = v * (q * e), r = v - m;
    f32x2 o; o.x = v.x < 0.f ? m.x : r.x; o.y = v.y < 0.f ? m.y : r.y; return o;
}

template <int ACT  > struct EpiBf16 {
    static constexpr bool PERM = true, AFTER_DRAIN = false; static_assert(ACT == 0 || ACT == 1, "EpiBf16: ACT is 0 (none) or 1 (gelu_pk)");
    bf16_t* O; int ldc; const float* bias; int split_cols; size_t split_stride; float scale0;
    __device__ __forceinline__ void operator()(const f32x4 (&acc)[2][2][4][2], const Unit& u, int wr, int wc, int fr, int fq) const {
        const int row0 = u.pm * BM + wr * 64 + fr; int colt = u.pn * BM; bf16_t* base = O;
        float sc = 1.f; if (split_cols) { const int t = colt / split_cols; base += (size_t)t * split_stride; colt -= t * split_cols; if (t == 0) sc = scale0; }
        const int col0 = colt + wc * 32 + 8 * fq, bcol0 = u.pn * BM + wc * 32 + 8 * fq;
        f32x4 bv[2][2];
#pragma unroll
        for (int bj = 0; bj < 2; ++bj)
#pragma unroll
            for (int n = 0; n < 2; ++n) bv[bj][n] = bias ? *(const f32x4*)(bias + bcol0 + bj * HALF + 4 * n) : (f32x4){0.f, 0.f, 0.f, 0.f};
#pragma unroll
        for (int ai = 0; ai < 2; ++ai)
#pragma unroll
            for (int m = 0; m < 4; ++m) { bf16_t* rowp = base + (size_t)(row0 + ai * HALF + m * 16) * ldc + col0;
#pragma unroll
                for (int bj = 0; bj < 2; ++bj) { f32x4 v0 = acc[ai][bj][m][0] + bv[bj][0], v1 = acc[ai][bj][m][1] + bv[bj][1];
                    if (ACT == 1) { f32x2 a = gelu_pk((f32x2){v0[0], v0[1]}), b = gelu_pk((f32x2){v0[2], v0[3]}), c = gelu_pk((f32x2){v1[0], v1[1]}), d = gelu_pk((f32x2){v1[2], v1[3]});
                        v0 = (f32x4){a.x, a.y, b.x, b.y}; v1 = (f32x4){c.x, c.y, d.x, d.y}; }
                    v0 = v0 * sc; v1 = v1 * sc; u32x4 w; w.x = cvt_pk_bf16(v0[0], v0[1]); w.y = cvt_pk_bf16(v0[2], v0[3]); w.z = cvt_pk_bf16(v1[0], v1[1]); w.w = cvt_pk_bf16(v1[2], v1[3]);
                    *(u32x4*)(rowp + bj * HALF) = w; } }
    }
};
__device__ __forceinline__ float fsigmoid(float x) { return __builtin_amdgcn_rcpf(1.0f + __builtin_amdgcn_exp2f(-1.4426950408889634f * x)); }
__device__ __forceinline__ float fsilu(float x) { return x * fsigmoid(x); }
__device__ __forceinline__ float flogsig16(float x) {
    const float ax = __builtin_fabsf(x);
    const float l = __builtin_amdgcn_logf(1.0f + __builtin_amdgcn_exp2f(-1.4426950408889634f * ax)) * 0.6931471805599453f;
    return (__builtin_fminf(x, 0.0f) - l) * 0.0625f;
}
__device__ __forceinline__ float bflo(unsigned w) { return __uint_as_float(w << 16); }
__device__ __forceinline__ float bfhi(unsigned w) { return __uint_as_float(w & 0xffff0000u); }

struct EpiProj {
    static constexpr bool PERM = true, AFTER_DRAIN = false, HAS_MID = false;
    bf16_t* QKV; bf16_t* PJ; const float* gbias;
    const float* cs; const float* qg; const float* kg; PG8_LAS float* X;
    __device__ __forceinline__ void mid(f32x4 (&acc)[2][2][4][2], const Unit& u, int wr, int wc, int fr, int fq) const {}
    __device__ __forceinline__ void operator()(const f32x4 (&acc)[2][2][4][2], const Unit& u, int wr, int wc, int fr, int fq) const {
        const int row0 = u.pm * BM + wr * 64 + fr, col0 = u.pn * BM + wc * 32 + 8 * fq;
        const int mode = u.pn < 20 ? 0 : (u.pn < 24 ? 1 : (u.pn < 40 ? 2 : 3));
        const bool isqkv = u.pn < 12;
        bf16_t* const O = isqkv ? QKV + (size_t)(u.pn >> 2) * ((size_t)32 << 20) + ((u.pn & 3) * BM + wc * 32 + 8 * fq) : PJ + ((u.pn - 12) * BM + wc * 32 + 8 * fq);
        const int ldc = isqkv ? 1024 : 7680;
        if (u.pn < 8) {
            const bool isq = u.pn < 4; const float* gg = isq ? qg : kg;
            asm volatile("" : "+v"(fr), "+v"(fq));
#pragma unroll
            for (int ai = 0; ai < 2; ++ai)
#pragma unroll
                for (int m = 0; m < 4; ++m)
#pragma unroll
                    for (int bj = 0; bj < 2; ++bj) { const f32x4 a = acc[ai][bj][m][0], b = acc[ai][bj][m][1];
                        float t = (a[0] * a[0] + a[1] * a[1]) + (a[2] * a[2] + a[3] * a[3]) + (b[0] * b[0] + b[1] * b[1]) + (b[2] * b[2] + b[3] * b[3]);
                        t += __shfl_xor(t, 16); t += __shfl_xor(t, 32);
                        if (fq == 0) X[((ai * HALF + wr * 64 + m * 16 + fr) * 2 + bj) * 4 + wc] = t; }
            asm volatile("s_waitcnt lgkmcnt(0)\n\ts_barrier" ::: "memory");
            const f32x4 g0 = *(const f32x4*)(gg + 32 * (wc & 1) + 8 * fq), g1 = *(const f32x4*)(gg + 32 * (wc & 1) + 8 * fq + 4);
            const bool ropew = (wc & 1) == 0; const float sgn = (fq == 0) ? -1.0f : 1.0f; const bool ropel = ropew && fq < 2;
            const float qs = isq ? (0.125f * 1.4426950408889634f) : 1.0f;
#pragma unroll
            for (int ai = 0; ai < 2; ++ai)
#pragma unroll
                for (int m = 0; m < 4; ++m) { const int rt = ai * HALF + wr * 64 + m * 16 + fr; const size_t row = (size_t)(u.pm * BM + rt);
                    f32x4 c0 = (f32x4){1.f, 1.f, 1.f, 1.f}, c1 = c0, s0 = (f32x4){0.f, 0.f, 0.f, 0.f}, s1 = s0;
                    if (ropel) { const f32x4* cp = (const f32x4*)(cs + row * 16); c0 = cp[0]; c1 = cp[1]; s0 = cp[2] * sgn; s1 = cp[3] * sgn; }
                    bf16_t* rowp = O + row * ldc;
#pragma unroll
                    for (int bj = 0; bj < 2; ++bj) { const float tot = X[(rt * 2 + bj) * 4 + wc] + X[(rt * 2 + bj) * 4 + (wc ^ 1)];
                        const float rstd = 1.0f / sqrtf(tot * (1.0f / 64.0f) + 1e-6f);
                        f32x4 v0 = acc[ai][bj][m][0] * rstd * g0, v1 = acc[ai][bj][m][1] * rstd * g1;
                        f32x4 o0, o1;
#pragma unroll
                        for (int e = 0; e < 4; ++e) { o0[e] = __shfl_xor(v0[e], 16); o1[e] = __shfl_xor(v1[e], 16); }
                        if (ropew) { v0 = v0 * c0 + o0 * s0; v1 = v1 * c1 + o1 * s1; }
                        v0 = v0 * qs; v1 = v1 * qs;
                        u32x4 w; w.x = cvt_pk_bf16(v0[0], v0[1]); w.y = cvt_pk_bf16(v0[2], v0[3]); w.z = cvt_pk_bf16(v1[0], v1[1]); w.w = cvt_pk_bf16(v1[2], v1[3]);
                        *(u32x4*)(rowp + bj * HALF) = w; } }
            return;
        }
        f32x4 bv[2][2];
#pragma unroll
        for (int bj = 0; bj < 2; ++bj)
#pragma unroll
            for (int n = 0; n < 2; ++n) bv[bj][n] = (mode == 3) ? *(const f32x4*)(gbias + (col0 - 10240) + bj * HALF + 4 * n) : (f32x4){0.f, 0.f, 0.f, 0.f};
#pragma unroll
        for (int ai = 0; ai < 2; ++ai)
#pragma unroll
            for (int m = 0; m < 4; ++m) { bf16_t* rowp = O + (size_t)(row0 + ai * HALF + m * 16) * ldc;
#pragma unroll
                for (int bj = 0; bj < 2; ++bj) { f32x4 v0 = acc[ai][bj][m][0], v1 = acc[ai][bj][m][1];
                    if (mode == 1) {
#pragma unroll
                        for (int e = 0; e < 4; ++e) { v0[e] = fsilu(v0[e]); v1[e] = fsilu(v1[e]); }
                    } else if (mode == 2) {
#pragma unroll
                        for (int e = 0; e < 4; ++e) { v0[e] = fsigmoid(v0[e]); v1[e] = fsigmoid(v1[e]); }
                    } else if (mode == 3) { v0 = v0 + bv[bj][0]; v1 = v1 + bv[bj][1];
#pragma unroll
                        for (int e = 0; e < 4; ++e) { v0[e] = flogsig16(v0[e]); v1[e] = flogsig16(v1[e]); }
                    }
                    u32x4 w; w.x = cvt_pk_bf16(v0[0], v0[1]); w.y = cvt_pk_bf16(v0[2], v0[3]); w.z = cvt_pk_bf16(v1[0], v1[1]); w.w = cvt_pk_bf16(v1[2], v1[3]);
                    *(u32x4*)(rowp + bj * HALF) = w; } }
    }
};

struct EpiMerge {
    static constexpr bool PERM = true, AFTER_DRAIN = false, HAS_MID = true;
    bf16_t* O; int ldc; const bf16_t* G; int ldg;
    __device__ __forceinline__ void mid(f32x4 (&acc)[2][2][4][2], const Unit& u, int wr, int wc, int fr, int fq) const {
        int fr_ = fr, fq_ = fq; asm volatile("" : "+v"(fr_), "+v"(fq_));
        const int row0 = u.pm * BM + wr * 64 + fr_, col0 = u.pn * BM + wc * 32 + 8 * fq_;
#pragma unroll
        for (int ai = 0; ai < 2; ++ai)
#pragma unroll
            for (int m = 0; m < 4; ++m) { const bf16_t* gp = G + (size_t)(row0 + ai * HALF + m * 16) * ldg + col0;
#pragma unroll
                for (int bj = 0; bj < 2; ++bj) { const u32x4 a = *(const u32x4*)(gp + 3072 + bj * HALF), b = *(const u32x4*)(gp + 5120 + bj * HALF);
                    f32x4 r0, r1;
                    r0[0] = bflo(a.x) * __builtin_amdgcn_rcpf(bflo(b.x)); r0[1] = bfhi(a.x) * __builtin_amdgcn_rcpf(bfhi(b.x)); r0[2] = bflo(a.y) * __builtin_amdgcn_rcpf(bflo(b.y)); r0[3] = bfhi(a.y) * __builtin_amdgcn_rcpf(bfhi(b.y));
                    r1[0] = bflo(a.z) * __builtin_amdgcn_rcpf(bflo(b.z)); r1[1] = bfhi(a.z) * __builtin_amdgcn_rcpf(bfhi(b.z)); r1[2] = bflo(a.w) * __builtin_amdgcn_rcpf(bflo(b.w)); r1[3] = bfhi(a.w) * __builtin_amdgcn_rcpf(bfhi(b.w));
                    acc[ai][bj][m][0] = acc[ai][bj][m][0] * r0; acc[ai][bj][m][1] = acc[ai][bj][m][1] * r1;
                    asm volatile("" : "+v"(acc[ai][bj][m][0]), "+v"(acc[ai][bj][m][1]) :: "memory"); } }
    }
    __device__ __forceinline__ void operator()(const f32x4 (&acc)[2][2][4][2], const Unit& u, int wr, int wc, int fr, int fq) const {
        const int row0 = u.pm * BM + wr * 64 + fr, col0 = u.pn * BM + wc * 32 + 8 * fq;
#pragma unroll
        for (int ai = 0; ai < 2; ++ai)
#pragma unroll
            for (int m = 0; m < 4; ++m) { const size_t r = (size_t)(row0 + ai * HALF + m * 16); const bf16_t* gp = G + r * ldg + col0; bf16_t* rowp = O + r * ldc + col0;
#pragma unroll
                for (int bj = 0; bj < 2; ++bj) { const u32x4 b = *(const u32x4*)(gp + 5120 + bj * HALF);
                    const f32x4 v0 = acc[ai][bj][m][0], v1 = acc[ai][bj][m][1];
                    u32x4 w; w.x = cvt_pk_bf16(v0[0] * bflo(b.x), v0[1] * bfhi(b.x)); w.y = cvt_pk_bf16(v0[2] * bflo(b.y), v0[3] * bfhi(b.y));
                    w.z = cvt_pk_bf16(v1[0] * bflo(b.z), v1[1] * bfhi(b.z)); w.w = cvt_pk_bf16(v1[2] * bflo(b.w), v1[3] * bfhi(b.w));
                    *(u32x4*)(rowp + bj * HALF) = w; } }
    }
};

template <bool BASE16, bool OUT16> struct EpiRes {
    static constexpr bool PERM = true, AFTER_DRAIN = false, HAS_MID = false;
    const void* base; void* out; int ldc; const float* mod; const float* bada; int goff; int rows_per_batch;
    __device__ __forceinline__ void mid(f32x4 (&acc)[2][2][4][2], const Unit& u, int wr, int wc, int fr, int fq) const {}
    __device__ __forceinline__ void operator()(const f32x4 (&acc)[2][2][4][2], const Unit& u, int wr, int wc, int fr, int fq) const {
        const int row0 = u.pm * BM + wr * 64 + fr, col0 = u.pn * BM + wc * 32 + 8 * fq;
        const int b = (u.pm * BM) / rows_per_batch;
        f32x4 gv[2][2];
#pragma unroll
        for (int bj = 0; bj < 2; ++bj)
#pragma unroll
            for (int n = 0; n < 2; ++n) gv[bj][n] = *(const f32x4*)(mod + b * 12288 + goff + col0 + bj * HALF + 4 * n) + *(const f32x4*)(bada + goff + col0 + bj * HALF + 4 * n);
#pragma unroll
        for (int ai = 0; ai < 2; ++ai)
#pragma unroll
            for (int m = 0; m < 4; ++m) { const size_t off = (size_t)(row0 + ai * HALF + m * 16) * ldc + col0;
#pragma unroll
                for (int bj = 0; bj < 2; ++bj) {
                    f32x4 b0, b1;
                    if constexpr (BASE16) { const u32x4 w = *(const u32x4*)((const bf16_t*)base + off + bj * HALF);
                        b0 = (f32x4){bflo(w.x), bfhi(w.x), bflo(w.y), bfhi(w.y)}; b1 = (f32x4){bflo(w.z), bfhi(w.z), bflo(w.w), bfhi(w.w)}; }
                    else { b0 = *(const f32x4*)((const float*)base + off + bj * HALF); b1 = *(const f32x4*)((const float*)base + off + bj * HALF + 4); }
                    const f32x4 o0 = b0 + gv[bj][0] * acc[ai][bj][m][0], o1 = b1 + gv[bj][1] * acc[ai][bj][m][1];
                    if constexpr (OUT16) { u32x4 w; w.x = cvt_pk_bf16(o0[0], o0[1]); w.y = cvt_pk_bf16(o0[2], o0[3]); w.z = cvt_pk_bf16(o1[0], o1[1]); w.w = cvt_pk_bf16(o1[2], o1[3]);
                        *(u32x4*)((bf16_t*)out + off + bj * HALF) = w; }
                    else { *(f32x4*)((float*)out + off + bj * HALF) = o0; *(f32x4*)((float*)out + off + bj * HALF + 4) = o1; } } }
    }
};

struct EpiRelu2 {
    static constexpr bool PERM = true, AFTER_DRAIN = false, HAS_MID = false;
    bf16_t* O; int ldc;
    __device__ __forceinline__ void mid(f32x4 (&acc)[2][2][4][2], const Unit& u, int wr, int wc, int fr, int fq) const {}
    __device__ __forceinline__ void operator()(const f32x4 (&acc)[2][2][4][2], const Unit& u, int wr, int wc, int fr, int fq) const {
        const int row0 = u.pm * BM + wr * 64 + fr, col0 = u.pn * BM + wc * 32 + 8 * fq;
#pragma unroll
        for (int ai = 0; ai < 2; ++ai)
#pragma unroll
            for (int m = 0; m < 4; ++m) { bf16_t* rowp = O + (size_t)(row0 + ai * HALF + m * 16) * ldc + col0;
#pragma unroll
                for (int bj = 0; bj < 2; ++bj) { f32x4 v0 = acc[ai][bj][m][0], v1 = acc[ai][bj][m][1];
#pragma unroll
                    for (int e = 0; e < 4; ++e) { const float a = __builtin_fmaxf(v0[e], 0.f), b = __builtin_fmaxf(v1[e], 0.f); v0[e] = a * a; v1[e] = b * b; }
                    u32x4 w; w.x = cvt_pk_bf16(v0[0], v0[1]); w.y = cvt_pk_bf16(v0[2], v0[3]); w.z = cvt_pk_bf16(v1[0], v1[1]); w.w = cvt_pk_bf16(v1[2], v1[3]);
                    *(u32x4*)(rowp + bj * HALF) = w; } }
    }
};

template <class Epi, class Sched, bool ALIGN_EPI = false, bool SP2 = false>
__device__ __forceinline__ void gemm_phase(PG8_LAS unsigned char* lds, const Gemm g, const Sched& S, const Epi& E) {
    const int tid = threadIdx.x, wid = __builtin_amdgcn_readfirstlane(tid >> 6), lane = tid & 63, wr = wid >> 2, wc = wid & 3, fr = lane & 15, fq = lane >> 4;
    const int K = g.K, nt = K / BK;
    unsigned voffA[2], voffB[2];
#pragma unroll
    for (int i = 0; i < 2; ++i) { int R, C; stage_rc(tid * 16 + i * 8192, R, C); const int Rb = Epi::PERM ? ((R & ~31) + perm32(R & 31)) : R;
        voffA[i] = (unsigned)(R * K + C) * 2u; voffB[i] = (unsigned)(Rb * K + C) * 2u; }
    const size_t kstep = (size_t)(BK * 2);
    const size_t hstep = (size_t)HALF * K * 2;
    const size_t tstep = 2 * hstep;
    const unsigned ldsw = (unsigned)wid * 1024u;
    const int aoff = lds_byte(wr * 64 + fr, fq * 8), boff = lds_byte(wc * 32 + fr, fq * 8);
#define PG8_SA(b, h) (((b) * 2 + (h)) * HTB)
#define PG8_SB(b, h) ((4 + (b) * 2 + (h)) * HTB)
#define PG8_STAGE(bufoff, gbase, voff) do { _Pragma("unroll") for (int _i = 0; _i < 2; ++_i) \
        __builtin_amdgcn_global_load_lds((const unsigned*)((const char*)(gbase) + (voff)[_i]), (PG8_LAS unsigned*)(lds + (bufoff) + ldsw + _i * 8192), 16, 0, 0); } while (0)
#define PG8_LDA(dst, b, h) do { _Pragma("unroll") for (int m = 0; m < 4; ++m) _Pragma("unroll") for (int k = 0; k < 2; ++k) dst[m][k] = *(const PG8_LAS bf16x8*)(lds + PG8_SA(b, h) + aoff + m * 2048 + k * 1024); } while (0)
#define PG8_LDB(dst, b, h) do { _Pragma("unroll") for (int n = 0; n < 2; ++n) _Pragma("unroll") for (int k = 0; k < 2; ++k) dst[n][k] = *(const PG8_LAS bf16x8*)(lds + PG8_SB(b, h) + boff + n * 2048 + k * 1024); } while (0)
#define PG8_MMA(ai, bj, At, Bt) do { __builtin_amdgcn_s_setprio(1); _Pragma("unroll") for (int m = 0; m < 4; ++m) _Pragma("unroll") for (int n = 0; n < 2; ++n) _Pragma("unroll") for (int k = 0; k < 2; ++k) \
        acc[ai][bj][m][n] = __builtin_amdgcn_mfma_f32_16x16x32_bf16(Bt[n][k], At[m][k], acc[ai][bj][m][n], 0, 0, 0); __builtin_amdgcn_s_setprio(0); } while (0)
#define PG8_WAIT_V(n) asm volatile("s_waitcnt vmcnt(" #n ")" ::: "memory")
#define PG8_WAIT_L(n) asm volatile("s_waitcnt lgkmcnt(" #n ")" ::: "memory")
#define PG8_BAR __builtin_amdgcn_s_barrier()
#define PG8_SCHED __builtin_amdgcn_sched_barrier(0)
    Unit cur, nxt; int ui = 0;
    if (!S.next(0, cur)) return;
    f32x4 acc[2][2][4][2];
#pragma unroll
    for (int a = 0; a < 2; ++a)
#pragma unroll
        for (int b = 0; b < 2; ++b)
#pragma unroll
            for (int m = 0; m < 4; ++m)
#pragma unroll
                for (int n = 0; n < 2; ++n) acc[a][b][m][n] = (f32x4){0.f, 0.f, 0.f, 0.f};
    bf16x8 At[4][2], B0[2][2], B1[2][2];
    const char* cA = (const char*)g.A + (size_t)cur.pm * tstep; const char* cB = (const char*)g.Bt + (size_t)cur.pn * tstep;
    S.a_ready(cur);
    if constexpr (SP2) {
        PG8_STAGE(PG8_SB(0, 0), cB, voffB); PG8_STAGE(PG8_SB(0, 1), cB + hstep, voffB); PG8_STAGE(PG8_SA(0, 0), cA, voffA); PG8_STAGE(PG8_SA(0, 1), cA + hstep, voffA);
        if (wr == 1) PG8_BAR;
        PG8_WAIT_V(2); PG8_BAR;
        PG8_STAGE(PG8_SB(1, 0), cB + kstep, voffB); PG8_STAGE(PG8_SA(1, 0), cA + kstep, voffA); PG8_STAGE(PG8_SB(1, 1), cB + hstep + kstep, voffB);
        PG8_WAIT_V(6); PG8_BAR;
    } else {
        PG8_STAGE(PG8_SB(0, 0), cB, voffB); PG8_STAGE(PG8_SA(0, 0), cA, voffA); PG8_STAGE(PG8_SB(0, 1), cB + hstep, voffB); PG8_STAGE(PG8_SA(0, 1), cA + hstep, voffA);
        if (wr == 1) PG8_BAR;
        PG8_WAIT_V(4); PG8_BAR;
        PG8_STAGE(PG8_SB(1, 0), cB + kstep, voffB); PG8_STAGE(PG8_SA(1, 0), cA + kstep, voffA); PG8_STAGE(PG8_SB(1, 1), cB + hstep + kstep, voffB);
        PG8_WAIT_V(6); PG8_BAR;
    }
    for (;;) {
        const bool has_next = S.next(ui + 1, nxt);
        const char* nA = has_next ? (const char*)g.A + (size_t)nxt.pm * tstep : cA; const char* nB = has_next ? (const char*)g.Bt + (size_t)nxt.pn * tstep : cB;
        for (int t = 0; t < nt; t += 2) {
            if constexpr (Epi::HAS_MID) { if (t == (nt >> 1)) E.mid(acc, cur, wr, wc, fr, fq); }
            const bool last = (t == nt - 2);
            const char* a1 = cA + (size_t)(t + 1) * kstep;
            const char* a2 = last ? nA : cA + (size_t)(t + 2) * kstep; const char* b2 = last ? nB : cB + (size_t)(t + 2) * kstep;
            const char* a3 = a2 + kstep; const char* b3 = b2 + kstep;
            if (last && has_next) S.a_ready(nxt);
            if constexpr (SP2) {
            PG8_LDB(B0, 0, 0); PG8_LDB(B1, 0, 1); PG8_SCHED; PG8_LDA(At, 0, 0); PG8_STAGE(PG8_SA(1, 1), a1 + hstep, voffA);
            PG8_WAIT_V(8); PG8_WAIT_L(0); PG8_BAR; PG8_MMA(0, 0, At, B0); PG8_MMA(0, 1, At, B1); PG8_BAR; PG8_SCHED;
            PG8_LDA(At, 0, 1); PG8_STAGE(PG8_SB(0, 0), b2, voffB); PG8_STAGE(PG8_SB(0, 1), b2 + hstep, voffB); PG8_STAGE(PG8_SA(0, 0), a2, voffA);
            PG8_WAIT_V(8); PG8_WAIT_L(0); PG8_BAR; PG8_MMA(1, 0, At, B0); PG8_MMA(1, 1, At, B1); PG8_BAR; PG8_SCHED;
            PG8_LDB(B0, 1, 0); PG8_LDB(B1, 1, 1); PG8_SCHED; PG8_LDA(At, 1, 0); PG8_STAGE(PG8_SA(0, 1), a2 + hstep, voffA);
            PG8_WAIT_V(8); PG8_WAIT_L(0); PG8_BAR; PG8_MMA(0, 0, At, B0); PG8_MMA(0, 1, At, B1); PG8_BAR; PG8_SCHED;
            PG8_LDA(At, 1, 1); PG8_STAGE(PG8_SB(1, 0), b3, voffB); PG8_STAGE(PG8_SB(1, 1), b3 + hstep, voffB); PG8_STAGE(PG8_SA(1, 0), a3, voffA);
            PG8_WAIT_V(8); PG8_WAIT_L(0); PG8_BAR; PG8_MMA(1, 0, At, B0); PG8_MMA(1, 1, At, B1); PG8_BAR; PG8_SCHED;
            } else {
            PG8_LDB(B0, 0, 0); PG8_SCHED; PG8_LDA(At, 0, 0); PG8_STAGE(PG8_SA(1, 1), a1 + hstep, voffA);
            PG8_WAIT_L(8); PG8_BAR; PG8_WAIT_L(0); PG8_MMA(0, 0, At, B0); PG8_BAR; PG8_SCHED;
            PG8_LDB(B1, 0, 1); PG8_STAGE(PG8_SB(0, 0), b2, voffB);
            PG8_BAR; PG8_WAIT_L(0); PG8_MMA(0, 1, At, B1); PG8_BAR;
            PG8_LDA(At, 0, 1); PG8_STAGE(PG8_SA(0, 0), a2, voffA);
            PG8_BAR; PG8_WAIT_L(0); PG8_MMA(1, 0, At, B0); PG8_BAR; PG8_SCHED;
            PG8_STAGE(PG8_SB(0, 1), b2 + hstep, voffB);
            PG8_WAIT_V(6); PG8_BAR; PG8_MMA(1, 1, At, B1); PG8_BAR;
            PG8_LDB(B0, 1, 0); PG8_SCHED; PG8_LDA(At, 1, 0); PG8_STAGE(PG8_SA(0, 1), a2 + hstep, voffA);
            PG8_WAIT_L(8); PG8_BAR; PG8_WAIT_L(0); PG8_MMA(0, 0, At, B0); PG8_BAR; PG8_SCHED;
            PG8_LDB(B1, 1, 1); PG8_STAGE(PG8_SB(1, 0), b3, voffB);
            PG8_BAR; PG8_WAIT_L(0); PG8_MMA(0, 1, At, B1); PG8_BAR;
            PG8_LDA(At, 1, 1); PG8_STAGE(PG8_SA(1, 0), a3, voffA);
            PG8_BAR; PG8_WAIT_L(0); PG8_MMA(1, 0, At, B0); PG8_BAR; PG8_SCHED;
            PG8_STAGE(PG8_SB(1, 1), b3 + hstep, voffB);
            PG8_WAIT_V(6); PG8_BAR; PG8_MMA(1, 1, At, B1); PG8_BAR;
            }
        }
        if constexpr (ALIGN_EPI) { if (wr == 0) PG8_BAR; }
        if constexpr (!Epi::AFTER_DRAIN) { E(acc, cur, wr, wc, fr, fq); S.done(cur); }
        if (!has_next) break;
#pragma unroll
        for (int a = 0; a < 2; ++a)
#pragma unroll
            for (int b = 0; b < 2; ++b)
#pragma unroll
                for (int m = 0; m < 4; ++m)
#pragma unroll
                    for (int n = 0; n < 2; ++n) acc[a][b][m][n] = (f32x4){0.f, 0.f, 0.f, 0.f};
        cur = nxt; cA = nA; cB = nB; ++ui;
        if constexpr (ALIGN_EPI) { if (wr == 1) PG8_BAR; }
    }
    PG8_WAIT_V(0);
    if constexpr (!ALIGN_EPI) { if (wr == 0) PG8_BAR; }
    PG8_BAR;
    if constexpr (Epi::AFTER_DRAIN) { E.fused(acc, cur, wr, wc, fr, fq, lds, wid, lane); S.done(cur); }
#undef PG8_SA
#undef PG8_SB
#undef PG8_STAGE
#undef PG8_LDA
#undef PG8_LDB
#undef PG8_MMA
#undef PG8_WAIT_V
#undef PG8_WAIT_L
#undef PG8_BAR
#undef PG8_SCHED
}
}

#ifndef PG8_SP2
#define PG8_SP2 true
#endif
#include <hip/hip_bf16.h>
#include <cmath>
namespace attn_body {
using bf16=__hip_bfloat16;
using bf16x8=__attribute__((ext_vector_type(8)))short;
using s16x4=__attribute__((ext_vector_type(4)))short;
using f32x16=__attribute__((ext_vector_type(16)))float;
using u32x4=__attribute__((ext_vector_type(4)))unsigned;
constexpr int SEQ=16384,D=64,DM=1024,OPITCH=2048;
constexpr int NW=8,QBLK=32,QB=QBLK*NW,KVBLK=64,NQB=SEQ/QB;
__device__ __forceinline__ int crow(int r,int hi){return (r&3)+8*(r>>2)+4*hi;}
#define SBAR() __builtin_amdgcn_sched_barrier(0)
__device__ __forceinline__ void cmask(f32x16&p0,f32x16&p1,int jb,int qrel,int hi){
  const float NEG=-INFINITY; int kb=64*jb+4*hi;
  #pragma unroll
  for(int r=0;r<16;++r){int kv=kb+(r&3)+8*(r>>2); if(kv>qrel)p0[r]=NEG; if(kv+32>qrel)p1[r]=NEG;}
}

constexpr int NSLOT=3, SLOTB=8192;
constexpr int VSLOTB=16384;
constexpr int LDS_K=0, LDS_V=NSLOT*SLOTB, LDS_WS=LDS_V+NSLOT*VSLOTB, LDS_OST=LDS_WS+NW*64*4, LDS_BYTES=LDS_OST+NW*4096;
constexpr float C2=0.125f*1.4426950408889634f;
__device__ __forceinline__ void glds16(const void*gsrc,unsigned lds_dst){unsigned keep;
  asm volatile("s_mov_b32 %0, m0\n\ts_mov_b32 m0, %2\n\ts_nop 0\n\tglobal_load_lds_dwordx4 %1, off\n\ts_mov_b32 m0, %0":"=&s"(keep):"v"(gsrc),"s"(lds_dst):"memory");}
__device__ __forceinline__ float max3f(float a,float b,float c){float r;asm("v_max3_f32 %0, %1, %2, %3":"=v"(r):"v"(a),"v"(b),"v"(c));return r;}
__device__ __forceinline__ float max2f(float a,float b){float r;asm("v_max_f32_e32 %0, %1, %2":"=v"(r):"v"(a),"v"(b));return r;}
__device__ __forceinline__ float fadd_s(float a,float b){float r;asm("v_add_f32_e32 %0, %1, %2":"=v"(r):"v"(a),"v"(b));return r;}
__device__ __forceinline__ float fsub_s(float a,float b){float r;asm("v_sub_f32_e32 %0, %1, %2":"=v"(r):"v"(a),"v"(b));return r;}
typedef float f32x2_t __attribute__((ext_vector_type(2))); typedef __bf16 bf16x2_t __attribute__((ext_vector_type(2)));
__device__ __forceinline__ unsigned cvtpk_s(float lo,float hi){f32x2_t v={lo,hi};bf16x2_t b=__builtin_convertvector(v,bf16x2_t);return __builtin_bit_cast(unsigned,b);}
#define WAIT_BAR(N) asm volatile("s_waitcnt vmcnt(" #N ") lgkmcnt(0)\n\ts_barrier":::"memory")

__device__ __forceinline__ void qkt(f32x16&p0,f32x16&p1,const char*Kslot,const bf16x8*qr,int r32,int hi){
  const f32x16 negm=f32x16{};
  const char*kb=Kslot+hi*1024+r32*16;
  #pragma unroll
  for(int d0=0;d0<4;++d0){
    const bf16x8 b0=*reinterpret_cast<const bf16x8*>(kb+d0*2048);
    const bf16x8 b1=*reinterpret_cast<const bf16x8*>(kb+d0*2048+512);
    if(d0==0){p0=__builtin_amdgcn_mfma_f32_32x32x16_bf16(b0,qr[0],negm,0,0,0);p1=__builtin_amdgcn_mfma_f32_32x32x16_bf16(b1,qr[0],negm,0,0,0);}
    else{p0=__builtin_amdgcn_mfma_f32_32x32x16_bf16(b0,qr[d0],p0,0,0,0);p1=__builtin_amdgcn_mfma_f32_32x32x16_bf16(b1,qr[d0],p1,0,0,0);}}
}
typedef __attribute__((address_space(3))) const char* lds_cptr;
typedef short v4i16_t __attribute__((ext_vector_type(4)));
__device__ __forceinline__ void kload8(bf16x8*kf,lds_cptr kp){
  kf[0]=*(const __attribute__((address_space(3))) bf16x8*)(kp);      kf[1]=*(const __attribute__((address_space(3))) bf16x8*)(kp+512);
  kf[2]=*(const __attribute__((address_space(3))) bf16x8*)(kp+2048); kf[3]=*(const __attribute__((address_space(3))) bf16x8*)(kp+2560);
  kf[4]=*(const __attribute__((address_space(3))) bf16x8*)(kp+4096); kf[5]=*(const __attribute__((address_space(3))) bf16x8*)(kp+4608);
  kf[6]=*(const __attribute__((address_space(3))) bf16x8*)(kp+6144); kf[7]=*(const __attribute__((address_space(3))) bf16x8*)(kp+6656);
}
__device__ __forceinline__ void kload2(bf16x8*kf,lds_cptr kp,int j){ kf[2*j]=*(const __attribute__((address_space(3))) bf16x8*)(kp+j*2048); kf[2*j+1]=*(const __attribute__((address_space(3))) bf16x8*)(kp+j*2048+512); }
__device__ __forceinline__ s16x4 vtr(lds_cptr p){ return __builtin_bit_cast(s16x4,__builtin_amdgcn_ds_read_tr16_b64_v4i16((__attribute__((address_space(3))) v4i16_t*)p)); }
__device__ __forceinline__ float rowmax(const f32x16&p0,const f32x16&p1){
  float a=max3f(p0[0],p0[1],p1[0]),b=max3f(p0[2],p0[3],p1[1]);a=max3f(a,p1[2],p1[3]);
  #pragma unroll
  for(int r=4;r<16;r+=4){a=max3f(a,p0[r],p0[r+1]);b=max3f(b,p0[r+2],p0[r+3]);a=max3f(a,p1[r],p1[r+1]);b=max3f(b,p1[r+2],p1[r+3]);}
  const float m=max2f(a,b);
  auto rr=__builtin_amdgcn_permlane32_swap(__float_as_uint(m),__float_as_uint(m),false,false);
  return max2f(__uint_as_float(rr[0]),__uint_as_float(rr[1]));
}
__device__ __forceinline__ void pv(f32x16*o,int vb,bf16x8 pa0,bf16x8 pa1,bf16x8 pa2,bf16x8 pa3){
  #pragma unroll
  for(int d0=0;d0<4;++d0){s16x4 lo[4],hi[4];
    #pragma unroll
    for(int ks=0;ks<4;++ks){
      asm volatile("ds_read_b64_tr_b16 %0,%1 offset:%c2":"=&v"(lo[ks]):"v"(vb),"i"(d0*4096+ks*1024):"memory");
      asm volatile("ds_read_b64_tr_b16 %0,%1 offset:%c2":"=&v"(hi[ks]):"v"(vb),"i"(d0*4096+ks*1024+512):"memory");}
    asm volatile("s_waitcnt lgkmcnt(0)":::"memory");SBAR();
    #define PK(k) (bf16x8){lo[k][0],lo[k][1],lo[k][2],lo[k][3],hi[k][0],hi[k][1],hi[k][2],hi[k][3]}
    o[d0]=__builtin_amdgcn_mfma_f32_32x32x16_bf16(pa0,PK(0),o[d0],0,0,0);
    o[d0]=__builtin_amdgcn_mfma_f32_32x32x16_bf16(pa1,PK(1),o[d0],0,0,0);
    o[d0]=__builtin_amdgcn_mfma_f32_32x32x16_bf16(pa2,PK(2),o[d0],0,0,0);
    o[d0]=__builtin_amdgcn_mfma_f32_32x32x16_bf16(pa3,PK(3),o[d0],0,0,0);
    #undef PK
  }
}

#ifndef ATTN_STORE16
#define ATTN_STORE16(p,v) (*(u32x4*)(p)=(v))
#endif
template<int THRL> __device__ __forceinline__ void attn_unit(int b,int qcol,int kcol,int vcol,int ocol,int qb,const bf16*Q,const bf16*__restrict__ K,const bf16*__restrict__ V,bf16*O,char*shm){
  int tid_=threadIdx.x; asm volatile("":"+v"(tid_));
  const int tid=tid_,lane=tid&63,r32=lane&31,hi=lane>>5; const int wid=__builtin_amdgcn_readfirstlane(tid>>6);
  const long rowbase=(long)b*SEQ; const int q0=qb*QB;
  const bf16*Qw=Q+(rowbase+q0+wid*QBLK)*DM+qcol;
  const bf16*Kh=K+rowbase*DM+kcol,*Vh=V+rowbase*DM+vcol;
  const unsigned lds0=(unsigned)(uintptr_t)shm;
  float*wsf=(float*)(shm+LDS_WS)+wid*64;
  const bf16*ksrc=Kh+(long)lane*DM+wid*8;
  const bf16*vsrc=Vh+(long)(16*(wid&3)+(lane>>2))*DM+(wid>>2)*32+(lane&3)*8;
  const unsigned kdst=lds0+LDS_K+wid*1024, vdst=lds0+LDS_V+wid*1024;
  #define DMA_K(t,slot) glds16(ksrc+(long)(t)*KVBLK*DM,(unsigned)__builtin_amdgcn_readfirstlane(kdst+(slot)))
  #define DMA_V(t,slot) do{ glds16(vsrc+(long)(t)*KVBLK*DM,(unsigned)__builtin_amdgcn_readfirstlane(vdst+2*(slot))); glds16(vsrc+(long)(t)*KVBLK*DM+64,(unsigned)__builtin_amdgcn_readfirstlane(vdst+2*(slot)+8192)); }while(0)
  const int vb0=(int)(lds0+LDS_V)+((lane>>4)&1)*32+(lane&3)*8+(4*hi+((lane&15)>>2))*64;
  const char*Kbase=shm+LDS_K; bf16x8 kf[8];
  const lds_cptr shm3=(lds_cptr)shm; const lds_cptr kp0=shm3+LDS_K+hi*1024+r32*16; const lds_cptr vp0=shm3+LDS_V+((lane>>4)&1)*32+(lane&3)*8+(4*hi+((lane&15)>>2))*64;
  const int NT=(q0+QB)/KVBLK;
  DMA_K(0,0);DMA_V(0,0);DMA_K(1,SLOTB);
  bf16x8 qr[4];
  #pragma unroll
  for(int d0=0;d0<4;++d0)qr[d0]=*reinterpret_cast<const bf16x8*>(&Qw[(long)r32*DM+d0*16+hi*8]);
  float l_reg=0.f;f32x16 o[4];o[0]=f32x16{};o[1]=f32x16{};o[2]=f32x16{};o[3]=f32x16{};
  const int qrel=wid*QBLK+r32;
  #define CMASK(P0,P1,t) do{int jb_=(t)-(NT-4); if(jb_>=0)cmask(P0,P1,jb_,qrel,hi);}while(0)
  f32x16 pA0,pA1,pB0,pB1;
  int sl_prev=0,sl_cur=0,sl_next=SLOTB;
  #define ROT() do{sl_prev=sl_cur;sl_cur=sl_next;sl_next=(sl_next==(NSLOT-1)*SLOTB)?0:sl_next+SLOTB;}while(0)
  DMA_K(2,2*SLOTB);
  WAIT_BAR(3);
  qkt(pA0,pA1,Kbase,qr,r32,hi);asm volatile("s_nop 15\n\ts_nop 7":"+v"(pA0),"+v"(pA1));CMASK(pA0,pA1,0);
  _Pragma("unroll") for(int r=0;r<16;++r){pA0[r]=__builtin_amdgcn_exp2f(pA0[r]);pA1[r]=__builtin_amdgcn_exp2f(pA1[r]);}
  WAIT_BAR(0);
  DMA_K(3,0);DMA_V(1,SLOTB);
  ROT();
  kload8(kf,kp0+sl_cur);
  WAIT_BAR(3);
  s16x4 vlo[8],vhi[8]; u32x4 pw0,pw1,pw2,pw3;
  #define PKW(P,B) cvtpk_s(P[B],P[B+1])
  #define PAF(k) __builtin_bit_cast(bf16x8,pw##k)
  #define VFR(i) (bf16x8){vlo[i][0],vlo[i][1],vlo[i][2],vlo[i][3],vhi[i][0],vhi[i][1],vhi[i][2],vhi[i][3]}
  #define PIN(x) asm volatile("":"+v"(x))
  #define MX3(a,b,c) __builtin_fmaxf(__builtin_fmaxf((a),(b)),(c))
  #define GAPA(MF,A0,A1,A2,A3,W0,W1,PW) do{ MF; sacc+=A0; sacc+=A1; sacc+=A2; sacc+=A3; PIN(sacc); W0; W1; PIN(PW); SBAR(); }while(0)
  #define EX(v) __builtin_amdgcn_exp2f(v)
  #define GAPB(MF,X,B) do{ MF; X[B]=EX(X[B]); X[B+1]=EX(X[B+1]); PIN(X); SBAR(); }while(0)
  #define VRD(i) do{ vlo[i]=vtr(vp_+(((i)>>2)*4096+((i)&3)*1024)); vhi[i]=vtr(vp_+(((i)>>2)*4096+((i)&3)*1024+512)); }while(0)
  #define VRD2(i) do{ vlo[i]=vtr(vp_+(8192+((i)>>2)*4096+((i)&3)*1024)); vhi[i]=vtr(vp_+(8192+((i)>>2)*4096+((i)&3)*1024+512)); SBAR(); }while(0)
  #define KRD(G,j) do{ if(G){ kload2(kf,kp0+sl_next,j); SBAR(); } }while(0)
  #define STEP(C0,C1,P0,P1,t,GK,GV,GL) do{ SBAR(); const f32x16 zero16=f32x16{}; \
    const lds_cptr vp_=vp0+2*sl_prev; \
    VRD(0); SBAR(); float sacc=(P0[0]+P0[1]); \
    GAPA(C0=__builtin_amdgcn_mfma_f32_32x32x16_bf16(kf[0],qr[0],zero16,0,0,0), P0[2],P0[3],P0[4],P0[5],     pw0[0]=PKW(P0,0), pw0[1]=PKW(P0,2), pw0); \
    VRD(4); SBAR(); GAPA(C1=__builtin_amdgcn_mfma_f32_32x32x16_bf16(kf[1],qr[0],zero16,0,0,0), P0[6],P0[7],P0[8],P0[9],     pw0[2]=PKW(P0,4), pw0[3]=PKW(P0,6), pw0); \
    VRD(1); SBAR(); GAPA(C0=__builtin_amdgcn_mfma_f32_32x32x16_bf16(kf[2],qr[1],C0,0,0,0),   P0[10],P0[11],P0[12],P0[13], pw1[0]=PKW(P0,8), pw1[1]=PKW(P0,10), pw1); \
    VRD(5); SBAR(); GAPA(C1=__builtin_amdgcn_mfma_f32_32x32x16_bf16(kf[3],qr[1],C1,0,0,0),   P0[14],P0[15],P1[0],P1[1],   pw1[2]=PKW(P0,12),pw1[3]=PKW(P0,14), pw1); \
    VRD(2); SBAR(); GAPA(C0=__builtin_amdgcn_mfma_f32_32x32x16_bf16(kf[4],qr[2],C0,0,0,0),   P1[2],P1[3],P1[4],P1[5],     pw2[0]=PKW(P1,0), pw2[1]=PKW(P1,2), pw2); \
    VRD(6); SBAR(); GAPA(C1=__builtin_amdgcn_mfma_f32_32x32x16_bf16(kf[5],qr[2],C1,0,0,0),   P1[6],P1[7],P1[8],P1[9],     pw2[2]=PKW(P1,4), pw2[3]=PKW(P1,6), pw2); \
    VRD(3); SBAR(); GAPA(C0=__builtin_amdgcn_mfma_f32_32x32x16_bf16(kf[6],qr[3],C0,0,0,0),   P1[10],P1[11],P1[12],P1[13], pw3[0]=PKW(P1,8), pw3[1]=PKW(P1,10), pw3); \
    VRD(7); SBAR(); GAPA(C1=__builtin_amdgcn_mfma_f32_32x32x16_bf16(kf[7],qr[3],C1,0,0,0),   P1[14],P1[15],0.f,0.f,       pw3[2]=PKW(P1,12),pw3[3]=PKW(P1,14), pw3); \
    l_reg+=sacc; \
    if(GK){DMA_K((t)+3,sl_cur);} if(GV){DMA_V((t)+1,sl_next);} \
    CMASK(C0,C1,t); \
    SBAR(); \
    GAPB(o[0]=__builtin_amdgcn_mfma_f32_32x32x16_bf16(PAF(0),VFR(0),o[0],0,0,0), C0,0); VRD2(0); \
    GAPB(o[1]=__builtin_amdgcn_mfma_f32_32x32x16_bf16(PAF(0),VFR(4),o[1],0,0,0), C0,2); VRD2(4); \
    GAPB(o[0]=__builtin_amdgcn_mfma_f32_32x32x16_bf16(PAF(1),VFR(1),o[0],0,0,0), C0,4); VRD2(1); \
    GAPB(o[1]=__builtin_amdgcn_mfma_f32_32x32x16_bf16(PAF(1),VFR(5),o[1],0,0,0), C0,6); VRD2(5); \
    GAPB(o[0]=__builtin_amdgcn_mfma_f32_32x32x16_bf16(PAF(2),VFR(2),o[0],0,0,0), C0,8); VRD2(2); \
    GAPB(o[1]=__builtin_amdgcn_mfma_f32_32x32x16_bf16(PAF(2),VFR(6),o[1],0,0,0), C0,10); VRD2(6); \
    GAPB(o[0]=__builtin_amdgcn_mfma_f32_32x32x16_bf16(PAF(3),VFR(3),o[0],0,0,0), C0,12); VRD2(3); \
    GAPB(o[1]=__builtin_amdgcn_mfma_f32_32x32x16_bf16(PAF(3),VFR(7),o[1],0,0,0), C0,14); VRD2(7); \
    GAPB(o[2]=__builtin_amdgcn_mfma_f32_32x32x16_bf16(PAF(0),VFR(0),o[2],0,0,0), C1,0); \
    KRD(GL,0); GAPB(o[3]=__builtin_amdgcn_mfma_f32_32x32x16_bf16(PAF(0),VFR(4),o[3],0,0,0), C1,2); \
    KRD(GL,1); GAPB(o[2]=__builtin_amdgcn_mfma_f32_32x32x16_bf16(PAF(1),VFR(1),o[2],0,0,0), C1,4); \
    KRD(GL,2); GAPB(o[3]=__builtin_amdgcn_mfma_f32_32x32x16_bf16(PAF(1),VFR(5),o[3],0,0,0), C1,6); \
    KRD(GL,3); GAPB(o[2]=__builtin_amdgcn_mfma_f32_32x32x16_bf16(PAF(2),VFR(2),o[2],0,0,0), C1,8); \
    GAPB(o[3]=__builtin_amdgcn_mfma_f32_32x32x16_bf16(PAF(2),VFR(6),o[3],0,0,0), C1,10); \
    GAPB(o[2]=__builtin_amdgcn_mfma_f32_32x32x16_bf16(PAF(3),VFR(3),o[2],0,0,0), C1,12); \
    GAPB(o[3]=__builtin_amdgcn_mfma_f32_32x32x16_bf16(PAF(3),VFR(7),o[3],0,0,0), C1,14); \
    }while(0)
  int t=1;
  #undef CMASK
  #define CMASK(P0,P1,t) do{}while(0)
  for(;t+5<NT;t+=2){
    STEP(pB0,pB1,pA0,pA1,t,true,true,true);     WAIT_BAR(3); ROT();
    STEP(pA0,pA1,pB0,pB1,t+1,true,true,true);   WAIT_BAR(3); ROT();
  }
  #undef CMASK
  #define CMASK(P0,P1,t) do{int jb_=(t)-(NT-4); if(jb_>=0)cmask(P0,P1,jb_,qrel,hi);}while(0)
  #define ENDW(tt) do{ if((tt)+3<NT){WAIT_BAR(3);} else if((tt)+2<NT){WAIT_BAR(2);} else {WAIT_BAR(0);} }while(0)
  for(;t+1<NT;t+=2){
    STEP(pB0,pB1,pA0,pA1,t,(t+3<NT),(t+1<NT),(t+1<NT));       ENDW(t);   ROT();
    STEP(pA0,pA1,pB0,pB1,t+1,(t+4<NT),(t+2<NT),(t+2<NT));     ENDW(t+1); ROT();
  }
  STEP(pB0,pB1,pA0,pA1,NT-1,false,false,false);
  { float sacc=pB0[0]+pB0[1]; _Pragma("unroll") for(int r=2;r<16;++r)sacc+=pB0[r]; _Pragma("unroll") for(int r=0;r<16;++r)sacc+=pB1[r]; l_reg+=sacc;
    pw0=(u32x4){PKW(pB0,0),PKW(pB0,2),PKW(pB0,4),PKW(pB0,6)};pw1=(u32x4){PKW(pB0,8),PKW(pB0,10),PKW(pB0,12),PKW(pB0,14)};pw2=(u32x4){PKW(pB1,0),PKW(pB1,2),PKW(pB1,4),PKW(pB1,6)};pw3=(u32x4){PKW(pB1,8),PKW(pB1,10),PKW(pB1,12),PKW(pB1,14)};
    SBAR(); pv(o,vb0+2*sl_cur,PAF(0),PAF(1),PAF(2),PAF(3)); }
  #undef PKW
  #undef PAF
  #undef VFR
  #undef PIN
  #undef MX3
  #undef GAPA
  #undef GAPB
  #undef EX
  #undef VRD
  #undef KRD
  #undef STEP
  #undef ENDW
  {auto rr=__builtin_amdgcn_permlane32_swap(__float_as_uint(l_reg),__float_as_uint(l_reg),false,false);l_reg=__uint_as_float(rr[0])+__uint_as_float(rr[1]);}
  if(hi==0)wsf[32+r32]=l_reg;asm volatile("s_waitcnt lgkmcnt(0)":::"memory");
  float rli[16];
  #pragma unroll
  for(int r=0;r<16;++r)rli[r]=__builtin_amdgcn_rcpf(wsf[32+crow(r,hi)]);
  bf16*Ow=O+(rowbase+q0+wid*QBLK)*OPITCH+ocol;
  { bf16*stg=(bf16*)(shm+LDS_OST)+wid*2048;
    #pragma unroll
    for(int hf=0;hf<2;++hf){
    #pragma unroll
    for(int r=0;r<16;++r){const int orow=crow(r,hi);
      #pragma unroll
      for(int d0=0;d0<2;++d0)stg[orow*64+d0*32+r32]=__float2bfloat16(o[2*hf+d0][r]*rli[r]);}
    asm volatile("s_waitcnt lgkmcnt(0)":::"memory");
    #pragma unroll
    for(int i=0;i<4;++i){const int row=i*8+(lane>>3),ch=lane&7; const u32x4 v=*(const u32x4*)(stg+row*64+ch*8); ATTN_STORE16(Ow+(long)row*OPITCH+hf*64+ch*8,v);}
    asm volatile("s_waitcnt lgkmcnt(0)":::"memory"); } }
  asm volatile("s_waitcnt lgkmcnt(0)\n\ts_barrier":::"memory");
  #undef DMA_K
  #undef DMA_V
  #undef CMASK
  #undef ROT
}
constexpr int ATTN_LDS_BYTES=LDS_BYTES;
#undef SBAR
#undef WAIT_BAR
}
#define LAS __attribute__((address_space(3)))
typedef unsigned short bf16;
typedef unsigned v4u __attribute__((ext_vector_type(4)));
typedef unsigned v2u __attribute__((ext_vector_type(2)));
typedef float f32x4 __attribute__((ext_vector_type(4)));
typedef float f32x16 __attribute__((ext_vector_type(16)));
typedef short bf16x8 __attribute__((ext_vector_type(8)));

constexpr int NWAVES = 8;
constexpr int BATCH = 2, SEQ = 16384, D = 2048, T = BATCH * SEQ, FF = 8192;
constexpr int NMOD = 6 * D;
constexpr int INW = 10256;
constexpr int NPROJ = 10752;
constexpr int PW = 7680;
constexpr int C_GQ = 0, C_GK = 512, C_GV = 1024, C_GR = 2048, C_SA = 3072, C_SB = 5120, C_LA = 7168;
constexpr float EPS = 1e-6f;
constexpr size_t MiB = 1u << 20;
constexpr size_t WS_CTL = 0, CTL_ZERO_BYTES = 1 * MiB;
constexpr size_t WS_DEC = 1 * MiB;
constexpr size_t WS_QCTR = 128 * 1024;
constexpr size_t WS_BAR = 256 * 1024;
constexpr size_t WS_WIN = 2 * MiB, WS_WP = 44 * MiB, WS_WOUT = 52 * MiB, WS_W1 = 60 * MiB, WS_W2 = 92 * MiB;
constexpr size_t WS_Q = 124 * MiB, WS_K = 188 * MiB, WS_V = 252 * MiB;
constexpr size_t WS_PROJ = 316 * MiB;
constexpr size_t WS_HID = 124 * MiB;
constexpr size_t WS_H1 = 640 * MiB;
constexpr size_t WS_MRG = 796 * MiB;
constexpr size_t WS_OGLA = 924 * MiB;
constexpr size_t WS_CS = 988 * MiB;
constexpr size_t WS_END = 990 * MiB;
constexpr int LDS_BYTES = 147456;
constexpr int REP_GLA = 1;

__device__ __forceinline__ unsigned f2bf(float f) { unsigned u = __builtin_bit_cast(unsigned, f); return (u + 0x7fffu + ((u >> 16) & 1u)) >> 16; }
__device__ __forceinline__ unsigned pk2(float lo, float hi) { return f2bf(lo) | (f2bf(hi) << 16); }
__device__ __forceinline__ float bf2f(unsigned short u) { return __uint_as_float((unsigned)u << 16); }
__device__ __forceinline__ float blo(unsigned w) { return __uint_as_float(w << 16); }
__device__ __forceinline__ float bhi(unsigned w) { return __uint_as_float(w & 0xffff0000u); }
__device__ __forceinline__ float wave_sum(float v) {
#pragma unroll
    for (int o = 1; o < 64; o <<= 1) v += __shfl_xor(v, o);
    return v;
}

#define XB_TMO      128
#define XB_XCNT(j)  (256  + 64 * (j))
#define XB_XSUB(j)  (1280 + 64 * (j))
#define XB_XGEN(j)  (2304 + 64 * (j))
#define XB_TOP      3328
#define XB_TOPGEN   3392
#define XCD_BAR_WORDS 3456
#define XB_SPIN_CAP (1u << 18)

__device__ __forceinline__ unsigned xb_ld(unsigned* p)              { return __hip_atomic_load(p, __ATOMIC_RELAXED, __HIP_MEMORY_SCOPE_AGENT); }
__device__ __forceinline__ unsigned xb_add(unsigned* p, unsigned v) { return __hip_atomic_fetch_add(p, v, __ATOMIC_RELAXED, __HIP_MEMORY_SCOPE_AGENT); }
__device__ __forceinline__ unsigned xb_xcc_id() { return (unsigned)__builtin_amdgcn_s_getreg((3 << 11) | 20) & 0xFu; }
#define XB_SPIN(cond, bar) do { unsigned _sp = 0; while (cond) { __builtin_amdgcn_s_sleep(1); \
    if ((++_sp & 255u) == 0u) { if (xb_ld(&(bar)[XB_TMO])) break; if (_sp > XB_SPIN_CAP) { atomicAdd(&(bar)[XB_TMO], 1u); break; } } } } while (0)

struct XcdBarrier {
    unsigned* bar; unsigned x;
    volatile LAS unsigned* st;
};

__device__ __forceinline__ XcdBarrier xcd_barrier_post(unsigned* bar, volatile LAS unsigned* st) {
    XcdBarrier b; b.bar = bar; b.x = xb_xcc_id(); b.st = st;
    if (threadIdx.x == 0) (void)xb_add(&bar[XB_XCNT(b.x)], 1u);
    return b;
}
__device__ __forceinline__ void xcd_barrier_complete(unsigned* bar, unsigned x, unsigned& nloc, unsigned& nx) {
    const unsigned G = gridDim.x * gridDim.y * gridDim.z;
    unsigned sum, cnt, mine, sp = 0u;
    for (;;) {
        sum = 0u; cnt = 0u; mine = 0u;
#pragma unroll
        for (unsigned j = 0; j < 16; ++j) { const unsigned c = xb_ld(&bar[XB_XCNT(j)]); sum += c; cnt += (c > 0u) ? 1u : 0u; mine = (j == x) ? c : mine; }
        if (sum == G) break;
        __builtin_amdgcn_s_sleep(1);
        if ((++sp & 255u) == 0u) { if (xb_ld(&bar[XB_TMO])) break; if (sp > XB_SPIN_CAP) { atomicAdd(&bar[XB_TMO], 1u); break; } }
    }
    nloc = mine > 0u ? mine : 1u; nx = cnt > 0u ? cnt : 1u;
}

__device__ __forceinline__ void xcd_barrier(const XcdBarrier& b) {
    asm volatile("s_waitcnt vmcnt(0)" ::: "memory");
    __syncthreads();
    if (threadIdx.x == 0) {
        unsigned* bar = b.bar;
        __builtin_amdgcn_s_waitcnt(0);
        unsigned nloc = b.st[0], nx = b.st[1];
        if (nloc == 0u) { xcd_barrier_complete(bar, b.x, nloc, nx); b.st[0] = nloc; b.st[1] = nx; }
        const unsigned old = xb_add(&bar[XB_XSUB(b.x)], 1u);
        const unsigned gen = old / nloc;
        if (old + 1u == (gen + 1u) * nloc) {
            __builtin_amdgcn_fence(__ATOMIC_RELEASE, "agent");
            asm volatile("s_waitcnt vmcnt(0)" ::: "memory");
            const unsigned og = xb_add(&bar[XB_TOP], 1u);
            const unsigned tg = og / nx;
            if (og + 1u == (tg + 1u) * nx) xb_add(&bar[XB_TOPGEN], 1u);
            else XB_SPIN(xb_ld(&bar[XB_TOPGEN]) == tg, bar);
            __builtin_amdgcn_fence(__ATOMIC_ACQUIRE, "agent");
            xb_add(&bar[XB_XGEN(b.x)], 1u);
            asm volatile("s_waitcnt vmcnt(0)" ::: "memory");
        } else {
            XB_SPIN(xb_ld(&bar[XB_XGEN(b.x)]) == gen, bar);
            __builtin_amdgcn_fence(__ATOMIC_ACQUIRE, "agent");
            asm volatile("s_waitcnt vmcnt(0)" ::: "memory");
        }
    }
    __syncthreads();
}

struct Frame {
    LAS unsigned char* lds;
    int tid, lane, wave, vcu, G;
};

namespace gla {
constexpr int QS = 272, KS = 144;
constexpr int QE_OFF = 0, KE_OFF = 17408, KDT_OFF = 34816, VT_OFF = 53248, ST_OFF = 62464, ATT_OFF = 79872, PT_OFF = 89088, DEC_OFF = 91136, END_OFF = 91648;
constexpr float L2E = 1.4426950408889634f;
__device__ __forceinline__ int crow(int r, int hi) { return (r & 3) + 8 * (r >> 2) + 4 * hi; }
__device__ __forceinline__ bf16x8 ld8(LAS unsigned char* p) { return *(LAS bf16x8*)p; }

__device__ __forceinline__ void gla_prep_item(LAS unsigned char* lds, bf16* P, float* DECB, int b, int h, int c) {
    int tid_ = threadIdx.x; asm volatile("" : "+v"(tid_));
    const int tid = tid_, col = tid & 127, part = tid >> 7;
    const size_t rbase = (size_t)b * SEQ + (size_t)c * 64;
    bf16* qp = P + (rbase + part * 16) * PW + C_GQ + h * 128 + col;
    bf16* kp = P + (rbase + part * 16) * PW + C_GK + h * 128 + col;
    const bf16* lp = P + (rbase + part * 16) * PW + C_LA + h * 128 + col;
    LAS float* PT = (LAS float*)(lds + PT_OFF);
    unsigned short cq[16], ck[16], cl[16];
#pragma unroll
    for (int r = 0; r < 16; ++r) { cq[r] = qp[(size_t)r * PW]; ck[r] = kp[(size_t)r * PW]; cl[r] = lp[(size_t)r * PW]; }
    float bb[16]; float run = 0.f;
#pragma unroll
    for (int r = 0; r < 16; ++r) { run += bf2f(cl[r]); bb[r] = run; }
    PT[part * 128 + col] = run;
    __syncthreads();
    float off = 0.f, tot = 0.f;
#pragma unroll
    for (int p = 0; p < 4; ++p) { const float x = PT[p * 128 + col]; tot += x; off += (p < part) ? x : 0.f; }
    unsigned kd[8];
#pragma unroll
    for (int r = 0; r < 16; ++r) {
        const float bv = bb[r] + off, q = bf2f(cq[r]), k = bf2f(ck[r]);
        const float qe = q * __builtin_amdgcn_exp2f(bv * L2E) * 0.08838834764831845f;
        const float ke = k * __builtin_amdgcn_exp2f(-bv * L2E);
        const float kdv = k * __builtin_amdgcn_exp2f((tot - bv) * L2E);
        qp[(size_t)r * PW] = (bf16)f2bf(qe); kp[(size_t)r * PW] = (bf16)f2bf(ke);
        if (r & 1) kd[r >> 1] |= f2bf(kdv) << 16; else kd[r >> 1] = f2bf(kdv);
    }
    bf16* kdp = P + (rbase + (col >> 1)) * PW + C_LA + h * 128 + (col & 1) * 64 + part * 16;
    *(v4u*)kdp = (v4u){kd[0], kd[1], kd[2], kd[3]}; *(v4u*)(kdp + 8) = (v4u){kd[4], kd[5], kd[6], kd[7]};
    if (part == 0) DECB[(size_t)(((b * 4 + h) * 256 + c)) * 128 + col] = __builtin_amdgcn_exp2f(tot * L2E);
    __syncthreads();
}

__device__ __forceinline__ void gla_unit(LAS unsigned char* lds, const bf16* P, const float* DECB, bf16* OG, int b, int h, int vs) {
    int tid_ = threadIdx.x; asm volatile("" : "+v"(tid_));
    const int tid = tid_, lane = tid & 63, wid = __builtin_amdgcn_readfirstlane(tid >> 6), r32 = lane & 31, hi = lane >> 5;
    const int trow = tid >> 4, tch = tid & 15;
    const size_t row0 = (size_t)b * SEQ;
    const bf16* qsrc = P + (row0 + trow) * PW + C_GQ + h * 128 + tch * 8;
    const bf16* ksrc = P + (row0 + trow) * PW + C_GK + h * 128 + tch * 8;
    const bf16* dsrc = P + (row0 + trow) * PW + C_LA + h * 128 + tch * 8;
    const bf16* vp = P + (row0 + (tid >> 3)) * PW + C_GV + h * 256 + vs * 64 + (tid & 7) * 8;
    const float* decp = DECB + (size_t)((b * 4 + h) * 256) * 128 + (tid & 31) * 4;
    f32x16 st[2];
#pragma unroll
    for (int r = 0; r < 16; ++r) { st[0][r] = 0.f; st[1][r] = 0.f; }
    if (tid < 128) *(LAS v4u*)(lds + ATT_OFF + (tid >> 2) * KS + 64 + (tid & 3) * 16) = (v4u){0u, 0u, 0u, 0u};
    v4u q0 = *(const v4u*)qsrc, q1 = *(const v4u*)(qsrc + (size_t)32 * PW), k0 = *(const v4u*)ksrc, k1 = *(const v4u*)(ksrc + (size_t)32 * PW);
    v4u d0 = *(const v4u*)dsrc, d1 = *(const v4u*)(dsrc + (size_t)32 * PW), cv = *(const v4u*)vp;
    f32x4 dc = *(const f32x4*)decp;
    constexpr int NC = SEQ / 64;
    for (int c = 0; c < NC; ++c) {
        *(LAS v4u*)(lds + QE_OFF + trow * QS + tch * 16) = q0; *(LAS v4u*)(lds + QE_OFF + (trow + 32) * QS + tch * 16) = q1;
        *(LAS v4u*)(lds + KE_OFF + trow * QS + tch * 16) = k0; *(LAS v4u*)(lds + KE_OFF + (trow + 32) * QS + tch * 16) = k1;
        { const int kk = 2 * trow + (tch >> 3), j0 = (tch & 7) * 8;
          *(LAS v4u*)(lds + KDT_OFF + kk * KS + j0 * 2) = d0; *(LAS v4u*)(lds + KDT_OFF + (kk + 64) * KS + j0 * 2) = d1; }
        if (tid < 32) *(LAS f32x4*)(lds + DEC_OFF + tid * 16) = dc;
        {
            const int j = tid >> 3, v0 = (tid & 7) * 8;
#pragma unroll
            for (int e = 0; e < 4; ++e) { const unsigned w = cv[e];
                *(LAS unsigned short*)(lds + VT_OFF + (v0 + 2 * e) * KS + j * 2) = (unsigned short)(w & 0xffffu);
                *(LAS unsigned short*)(lds + VT_OFF + (v0 + 2 * e + 1) * KS + j * 2) = (unsigned short)(w >> 16); }
        }
        if (wid >= 4) { const int kblk = wid - 4;
#pragma unroll
            for (int vb = 0; vb < 2; ++vb)
#pragma unroll
            for (int g = 0; g < 4; ++g)
                *(LAS v2u*)(lds + ST_OFF + (vb * 32 + r32) * QS + (kblk * 32 + 8 * g + 4 * hi) * 2) = (v2u){pk2(st[vb][4 * g], st[vb][4 * g + 1]), pk2(st[vb][4 * g + 2], st[vb][4 * g + 3])};
        }
        {
            const size_t nx = (size_t)((c + 1 < NC) ? (c + 1) : c) * 64 * PW;
            q0 = *(const v4u*)(qsrc + nx); q1 = *(const v4u*)(qsrc + nx + (size_t)32 * PW); k0 = *(const v4u*)(ksrc + nx); k1 = *(const v4u*)(ksrc + nx + (size_t)32 * PW);
            d0 = *(const v4u*)(dsrc + nx); d1 = *(const v4u*)(dsrc + nx + (size_t)32 * PW); cv = *(const v4u*)(vp + nx);
            dc = *(const f32x4*)(decp + (size_t)((c + 1 < NC) ? (c + 1) : c) * 128);
        }
        asm volatile("s_waitcnt lgkmcnt(0)\n\ts_barrier" ::: "memory");
        if (wid < 3) {
            const int jb = (wid == 2) ? 1 : 0, ib = (wid >= 1) ? 1 : 0;
            f32x16 a;
#pragma unroll
            for (int r = 0; r < 16; ++r) a[r] = 0.f;
#pragma unroll
            for (int s = 0; s < 8; ++s) {
                const bf16x8 ka = ld8(lds + KE_OFF + (jb * 32 + r32) * QS + (16 * s + 8 * hi) * 2);
                const bf16x8 qb = ld8(lds + QE_OFF + (ib * 32 + r32) * QS + (16 * s + 8 * hi) * 2);
                a = __builtin_amdgcn_mfma_f32_32x32x16_bf16(ka, qb, a, 0, 0, 0);
            }
            const int ig = ib * 32 + r32;
#pragma unroll
            for (int g = 0; g < 4; ++g) { const int j0 = jb * 32 + 8 * g + 4 * hi;
                const float x0 = (j0 + 0 <= ig) ? a[4 * g + 0] : 0.f, x1 = (j0 + 1 <= ig) ? a[4 * g + 1] : 0.f, x2 = (j0 + 2 <= ig) ? a[4 * g + 2] : 0.f, x3 = (j0 + 3 <= ig) ? a[4 * g + 3] : 0.f;
                *(LAS v2u*)(lds + ATT_OFF + ig * KS + j0 * 2) = (v2u){pk2(x0, x1), pk2(x2, x3)}; }
        } else if (wid >= 4) {
            const int kblk = wid - 4;
#pragma unroll
            for (int g = 0; g < 4; ++g) { const f32x4 d = *(LAS f32x4*)(lds + DEC_OFF + (kblk * 32 + 8 * g + 4 * hi) * 4);
#pragma unroll
                for (int vb = 0; vb < 2; ++vb) { st[vb][4 * g] *= d[0]; st[vb][4 * g + 1] *= d[1]; st[vb][4 * g + 2] *= d[2]; st[vb][4 * g + 3] *= d[3]; } }
#pragma unroll
            for (int s = 0; s < 4; ++s) {
                const bf16x8 ka = ld8(lds + KDT_OFF + (kblk * 32 + r32) * KS + (16 * s + 8 * hi) * 2);
                const bf16x8 v0 = ld8(lds + VT_OFF + r32 * KS + (16 * s + 8 * hi) * 2);
                const bf16x8 v1 = ld8(lds + VT_OFF + (32 + r32) * KS + (16 * s + 8 * hi) * 2);
                st[0] = __builtin_amdgcn_mfma_f32_32x32x16_bf16(ka, v0, st[0], 0, 0, 0);
                st[1] = __builtin_amdgcn_mfma_f32_32x32x16_bf16(ka, v1, st[1], 0, 0, 0);
            }
        }
        asm volatile("s_waitcnt lgkmcnt(0)\n\ts_barrier" ::: "memory");
        if (wid < 4) {
            const int ib = wid & 1, vb = wid >> 1;
            f32x16 o;
#pragma unroll
            for (int r = 0; r < 16; ++r) o[r] = 0.f;
#pragma unroll
            for (int s = 0; s < 8; ++s) {
                const bf16x8 qa = ld8(lds + QE_OFF + (ib * 32 + r32) * QS + (16 * s + 8 * hi) * 2);
                const bf16x8 sb = ld8(lds + ST_OFF + (vb * 32 + r32) * QS + (16 * s + 8 * hi) * 2);
                o = __builtin_amdgcn_mfma_f32_32x32x16_bf16(qa, sb, o, 0, 0, 0);
            }
#pragma unroll
            for (int s = 0; s < 4; ++s) {
                const bf16x8 aa = ld8(lds + ATT_OFF + (ib * 32 + r32) * KS + (16 * s + 8 * hi) * 2);
                const bf16x8 vv = ld8(lds + VT_OFF + (vb * 32 + r32) * KS + (16 * s + 8 * hi) * 2);
                o = __builtin_amdgcn_mfma_f32_32x32x16_bf16(aa, vv, o, 0, 0, 0);
            }
            bf16* op = OG + (row0 + (size_t)c * 64 + ib * 32) * 1024 + h * 256 + vs * 64 + vb * 32 + r32;
#pragma unroll
            for (int r = 0; r < 16; ++r) op[(size_t)crow(r, hi) * 1024] = (bf16)f2bf(o[r]);
        }
        asm volatile("s_waitcnt lgkmcnt(0)\n\ts_barrier" ::: "memory");
    }
}
}

__device__ __forceinline__ void transpose_item(const float* W, int ldw, int src_c0, bf16* WT, int ldt, int dst_r0, int dst_k0, int nblk, LAS float* scr, int item, int lane) {
    const int kb = item / nblk, nb = item % nblk, k0 = 64 * kb, n0 = 32 * nb;
    float tv[32];
#pragma unroll
    for (int i = 0; i < 32; ++i) { const int kk = 2 * i + (lane >> 5); tv[i] = W[(size_t)(k0 + kk) * ldw + src_c0 + n0 + (lane & 31)]; }
#pragma unroll
    for (int i = 0; i < 32; ++i) { const int kk = 2 * i + (lane >> 5); scr[kk * 33 + (lane & 31)] = tv[i]; }
    asm volatile("s_waitcnt lgkmcnt(0)" ::: "memory");
    const int c = lane & 7;
#pragma unroll
    for (int j = 0; j < 4; ++j) { const int n = (lane >> 3) + 8 * j; const LAS float* s = scr + (8 * c) * 33 + n;
        v4u o; o.x = pk2(s[0 * 33], s[1 * 33]); o.y = pk2(s[2 * 33], s[3 * 33]); o.z = pk2(s[4 * 33], s[5 * 33]); o.w = pk2(s[6 * 33], s[7 * 33]);
        *(v4u*)(WT + (size_t)(dst_r0 + n0 + n) * ldt + dst_k0 + k0 + 8 * c) = o; }
    asm volatile("s_waitcnt lgkmcnt(0)" ::: "memory");
}

struct Args {
    const float* x; const float* c; const int* pos; const float* w_ada; const float* b_ada; const float* norm1_g; const float* w_in;
    const float* qn_g; const float* kn_g; const float* lq1; const float* lk1; const float* lq2; const float* lk2; const float* subln_g;
    const float* gate_up; const float* gate_bias; const float* gout_g; const float* w_pa; const float* w_pb; const float* w_out; const float* norm2_g;
    const float* w1; const float* w2; float* out; unsigned char* ws; int ph_lo, ph_hi;
};

__device__ __forceinline__ void p0_prologue(const Frame& F, const Args& a) {
    unsigned char* ws = a.ws;
    bf16* Wt_in = (bf16*)(ws + WS_WIN); bf16* Wt_p = (bf16*)(ws + WS_WP); bf16* Wt_out = (bf16*)(ws + WS_WOUT); bf16* Wt_1 = (bf16*)(ws + WS_W1); bf16* Wt_2 = (bf16*)(ws + WS_W2);
    float* modacc = (float*)(ws + WS_CTL);
    {
        LAS float* sc = (LAS float*)(F.lds + 140000);
        for (int it = blockIdx.x; it < 32 * 6; it += F.G) {
            const int kc = it / 6, jc = it % 6;
            __syncthreads();
            if (F.tid < 128) { const int bb = F.tid >> 6, kk = F.tid & 63; const float cv = a.c[bb * D + kc * 64 + kk]; sc[F.tid] = cv / (1.0f + __expf(-cv)); }
            __syncthreads();
            const int j = jc * 2048 + F.tid * 4;
            f32x4 a0 = (f32x4){0.f, 0.f, 0.f, 0.f}, a1 = (f32x4){0.f, 0.f, 0.f, 0.f};
            const float* wp = a.w_ada + (size_t)(kc * 64) * NMOD + j;
#pragma unroll 8
            for (int kk = 0; kk < 64; ++kk) { const f32x4 w = *(const f32x4*)(wp + (size_t)kk * NMOD); a0 += w * sc[kk]; a1 += w * sc[64 + kk]; }
#pragma unroll
            for (int e = 0; e < 4; ++e) { unsafeAtomicAdd(modacc + j + e, a0[e]); unsafeAtomicAdd(modacc + NMOD + j + e, a1[e]); }
        }
        __syncthreads();
    }
    LAS float* scr = (LAS float*)(F.lds + F.wave * 16384);
    const int gw = F.vcu * NWAVES + F.wave, NGW = F.G * NWAVES;
    constexpr int I_A = 32 * 192, I_B = 32 * 128, I_C = 16 * 64, I_D = 16 * 64, I_E = 32 * 64, I_F = 32 * 256, I_G = 128 * 64;
    constexpr int NITEMS = I_A + I_B + I_C + I_D + I_E + I_F + I_G;
    (void)NITEMS; (void)Wt_p; (void)Wt_out; (void)Wt_1; (void)Wt_2;
    for (int it = gw; it < I_A + I_B; it += NGW) {
        int r = it;
        if (r < I_A) { transpose_item(a.w_in, INW, 0, Wt_in, D, 0, 0, 192, scr, r, F.lane); continue; } r -= I_A;
        transpose_item(a.w_in, INW, 6160, Wt_in, D, 6144, 0, 128, scr, r, F.lane);
    }
    for (int idx = blockIdx.x * 512 + F.tid; idx < 512 * 256; idx += F.G * 512) {
        const int n = idx & 511, kc = idx >> 9;
        float up[16];
#pragma unroll
        for (int r = 0; r < 16; ++r) up[r] = a.gate_up[r * 512 + n];
        float o[8];
#pragma unroll
        for (int e = 0; e < 8; ++e) { const float* wr = a.w_in + (size_t)(kc * 8 + e) * INW + 6144; float s = 0.f;
#pragma unroll
            for (int r = 0; r < 16; ++r) s += wr[r] * up[r];
            o[e] = s; }
        *(v4u*)(Wt_in + (size_t)(10240 + n) * D + kc * 8) = (v4u){pk2(o[0], o[1]), pk2(o[2], o[3]), pk2(o[4], o[5]), pk2(o[6], o[7])};
    }
}

__device__ __forceinline__ void late_transposes(const Frame& F, const Args& a, int slot, int nslots) {
    unsigned char* ws = a.ws;
    bf16* Wt_p = (bf16*)(ws + WS_WP); bf16* Wt_out = (bf16*)(ws + WS_WOUT); bf16* Wt_1 = (bf16*)(ws + WS_W1); bf16* Wt_2 = (bf16*)(ws + WS_W2);
    LAS float* scr = (LAS float*)(F.lds + F.wave * 16384);
    constexpr int I_C = 16 * 64, I_D = 16 * 64, I_E = 32 * 64, I_F = 32 * 256, I_G = 128 * 64;
    for (int it = slot * NWAVES + F.wave; it < I_C + I_D + I_E + I_F + I_G; it += nslots * NWAVES) {
        int r = it;
        if (r < I_C) { transpose_item(a.w_pa, D, 0, Wt_p, D, 0, 0, 64, scr, r, F.lane); continue; } r -= I_C;
        if (r < I_D) { transpose_item(a.w_pb, D, 0, Wt_p, D, 0, 1024, 64, scr, r, F.lane); continue; } r -= I_D;
        if (r < I_E) { transpose_item(a.w_out, D, 0, Wt_out, D, 0, 0, 64, scr, r, F.lane); continue; } r -= I_E;
        if (r < I_F) { transpose_item(a.w1, FF, 0, Wt_1, D, 0, 0, 256, scr, r, F.lane); continue; } r -= I_F;
        transpose_item(a.w2, D, 0, Wt_2, FF, 0, 0, 64, scr, r, F.lane);
    }
    __syncthreads();
}

template <bool SRC16> __device__ __forceinline__ void modnorm_phase(const Frame& F, const Args& a, const void* __restrict__ srcv, bf16* __restrict__ dst, const float* g, int shift_off, int scale_off) {
    const float* __restrict__ src = (const float*)srcv; const bf16* __restrict__ src16 = (const bf16*)srcv;
    const float* modacc = (const float*)(a.ws + WS_CTL);
    const int gw = F.vcu * NWAVES + F.wave, NGW = F.G * NWAVES;
#pragma unroll 1
    for (int b = 0; b < BATCH; ++b) {
        f32x4 A[8], B[8];
#pragma unroll
        for (int j = 0; j < 8; ++j) { const int d = (F.lane + 64 * j) * 4;
            const f32x4 gg = *(const f32x4*)(g + d);
            const f32x4 sc = *(const f32x4*)(modacc + b * NMOD + scale_off + d) + *(const f32x4*)(a.b_ada + scale_off + d);
            const f32x4 sh = *(const f32x4*)(modacc + b * NMOD + shift_off + d) + *(const f32x4*)(a.b_ada + shift_off + d);
            A[j] = gg * (sc + 1.0f); B[j] = sh; }
        const int mend = (b + 1) * SEQ;
#pragma unroll 1
        for (int m = b * SEQ + gw; m < mend; m += 2 * NGW) {
            const int m1 = (m + NGW < mend) ? m + NGW : m;
            f32x4 v[8], w[8]; float s0 = 0.f, s1 = 0.f;
            if constexpr (SRC16) {
                const v2u* x0 = (const v2u*)(src16 + (size_t)m * D) + F.lane; const v2u* x1 = (const v2u*)(src16 + (size_t)m1 * D) + F.lane;
                v2u rv[8], rw[8];
#pragma unroll
                for (int j = 0; j < 8; ++j) { rv[j] = x0[64 * j]; rw[j] = x1[64 * j]; }
#pragma unroll
                for (int j = 0; j < 8; ++j) { v[j] = (f32x4){blo(rv[j].x), bhi(rv[j].x), blo(rv[j].y), bhi(rv[j].y)}; w[j] = (f32x4){blo(rw[j].x), bhi(rw[j].x), blo(rw[j].y), bhi(rw[j].y)}; }
            } else {
                const f32x4* x0 = (const f32x4*)(src + (size_t)m * D) + F.lane; const f32x4* x1 = (const f32x4*)(src + (size_t)m1 * D) + F.lane;
#pragma unroll
                for (int j = 0; j < 8; ++j) { v[j] = x0[64 * j]; w[j] = x1[64 * j]; }
            }
#pragma unroll
            for (int j = 0; j < 8; ++j) { s0 += (v[j].x * v[j].x + v[j].y * v[j].y) + (v[j].z * v[j].z + v[j].w * v[j].w); s1 += (w[j].x * w[j].x + w[j].y * w[j].y) + (w[j].z * w[j].z + w[j].w * w[j].w); }
            const float r0 = 1.0f / sqrtf(wave_sum(s0) * (1.0f / D) + EPS), r1 = 1.0f / sqrtf(wave_sum(s1) * (1.0f / D) + EPS);
            v2u* o0 = (v2u*)(dst + (size_t)m * D) + F.lane; v2u* o1 = (v2u*)(dst + (size_t)m1 * D) + F.lane;
#pragma unroll
            for (int j = 0; j < 8; ++j) { const f32x4 y = v[j] * r0 * A[j] + B[j]; o0[64 * j] = (v2u){pk2(y.x, y.y), pk2(y.z, y.w)}; if (j & 1) asm volatile("" ::: "memory"); }
#pragma unroll
            for (int j = 0; j < 8; ++j) { const f32x4 y = w[j] * r1 * A[j] + B[j]; o1[64 * j] = (v2u){pk2(y.x, y.y), pk2(y.z, y.w)}; if (j & 1) asm volatile("" ::: "memory"); }
        }
    }
}

__device__ __forceinline__ void rope_table(const Frame& F, const Args& a) {
    float* CS = (float*)(a.ws + WS_CS);
    const double invf[8] = {1.0, 0.19392274474868576, 0.03760603093086393, 0.007292664737217109, 0.001414213562373095, 0.0002742481756762073, 5.318295896944988e-05, 1.031338537721246e-05};
    for (int idx = blockIdx.x * 512 + F.tid; idx < T * 8; idx += F.G * 512) {
        const int m = idx >> 3, i = idx & 7;
        double f = invf[0];
#pragma unroll
        for (int k = 1; k < 8; ++k) f = (i == k) ? invf[k] : f;
        double rev = (double)a.pos[m] * f * 0.15915494309189535; rev -= __builtin_floor(rev);
        CS[m * 16 + i] = __builtin_amdgcn_cosf((float)rev); CS[m * 16 + 8 + i] = __builtin_amdgcn_sinf((float)rev);
    }
}

__device__ __forceinline__ void combine_phase(const Frame& F, const Args& a, const bf16* __restrict__ OT, bf16* __restrict__ Y) {
    const bf16* __restrict__ P = (const bf16*)(a.ws + WS_PROJ); const bf16* __restrict__ OG = (const bf16*)(a.ws + WS_OGLA);
    const int gw = F.vcu * NWAVES + F.wave, NGW = F.G * NWAVES;
    const float d1 = wave_sum(a.lq1[F.lane] * a.lk1[F.lane]), d2 = wave_sum(a.lq2[F.lane] * a.lk2[F.lane]);
    const float lam = __expf(d1) - __expf(d2) + 0.2f;
    const int l16 = F.lane & 15, h4 = F.lane >> 4;
    float sg[8];
#pragma unroll
    for (int e = 0; e < 8; ++e) sg[e] = a.subln_g[l16 * 8 + e] * 0.8f;
    float og[16];
#pragma unroll
    for (int e = 0; e < 16; ++e) og[e] = a.gout_g[l16 * 16 + e];
    for (int m = gw; m < T; m += NGW) {
        const bf16* ot = OT + (size_t)m * D; bf16* y = Y + (size_t)m * D;
        const int vh = l16 >> 3, d = (l16 & 7) * 8;
        v4u a0[2], a1[2];
#pragma unroll
        for (int pass = 0; pass < 2; ++pass) { const int h = pass * 4 + h4; a0[pass] = *(const v4u*)(ot + ((h * 2 + 0) * 2 + vh) * 64 + d); a1[pass] = *(const v4u*)(ot + ((h * 2 + 1) * 2 + vh) * 64 + d); }
        const bf16* gp = OG + (size_t)m * 1024 + h4 * 256 + l16 * 16; const bf16* rp = P + (size_t)m * PW + C_GR + h4 * 256 + l16 * 16;
        const v4u w0 = *(const v4u*)gp, w1 = *(const v4u*)(gp + 8), r0 = *(const v4u*)rp, r1 = *(const v4u*)(rp + 8);
#pragma unroll
        for (int pass = 0; pass < 2; ++pass) {
            const int h = pass * 4 + h4;
            const v4u u0 = a0[pass], u1 = a1[pass];
            float o[8] = {blo(u0.x) - lam * blo(u1.x), bhi(u0.x) - lam * bhi(u1.x), blo(u0.y) - lam * blo(u1.y), bhi(u0.y) - lam * bhi(u1.y),
                          blo(u0.z) - lam * blo(u1.z), bhi(u0.z) - lam * bhi(u1.z), blo(u0.w) - lam * blo(u1.w), bhi(u0.w) - lam * bhi(u1.w)};
            float ss = 0.f;
#pragma unroll
            for (int e = 0; e < 8; ++e) ss += o[e] * o[e];
            ss += __shfl_xor(ss, 1); ss += __shfl_xor(ss, 2); ss += __shfl_xor(ss, 4); ss += __shfl_xor(ss, 8);
            const float rstd = 1.0f / sqrtf(ss * (1.0f / 128.0f) + EPS);
#pragma unroll
            for (int e = 0; e < 8; ++e) o[e] = o[e] * rstd * sg[e];
            *(v4u*)(y + h * 128 + l16 * 8) = (v4u){pk2(o[0], o[1]), pk2(o[2], o[3]), pk2(o[4], o[5]), pk2(o[6], o[7])};
        }
        {
            float o[16] = {blo(w0.x), bhi(w0.x), blo(w0.y), bhi(w0.y), blo(w0.z), bhi(w0.z), blo(w0.w), bhi(w0.w), blo(w1.x), bhi(w1.x), blo(w1.y), bhi(w1.y), blo(w1.z), bhi(w1.z), blo(w1.w), bhi(w1.w)};
            const float rr[16] = {blo(r0.x), bhi(r0.x), blo(r0.y), bhi(r0.y), blo(r0.z), bhi(r0.z), blo(r0.w), bhi(r0.w), blo(r1.x), bhi(r1.x), blo(r1.y), bhi(r1.y), blo(r1.z), bhi(r1.z), blo(r1.w), bhi(r1.w)};
            float ss = 0.f;
#pragma unroll
            for (int e = 0; e < 16; ++e) ss += o[e] * o[e];
            ss += __shfl_xor(ss, 1); ss += __shfl_xor(ss, 2); ss += __shfl_xor(ss, 4); ss += __shfl_xor(ss, 8);
            const float rstd = 1.0f / sqrtf(ss * (1.0f / 256.0f) + EPS);
#pragma unroll
            for (int e = 0; e < 16; ++e) o[e] = o[e] * rstd * og[e] * rr[e];
            bf16* yp = y + 1024 + h4 * 256 + l16 * 16;
            *(v4u*)yp = (v4u){pk2(o[0], o[1]), pk2(o[2], o[3]), pk2(o[4], o[5]), pk2(o[6], o[7])};
            *(v4u*)(yp + 8) = (v4u){pk2(o[8], o[9]), pk2(o[10], o[11]), pk2(o[12], o[13]), pk2(o[14], o[15])};
        }
    }
}

__global__ void __launch_bounds__(NWAVES * 64, 2) mega_fwd(Args args) {
    extern __shared__ __attribute__((aligned(16))) unsigned char lds[];
    cg::grid_group grid = cg::this_grid();
    Frame F;
    F.lds = (LAS unsigned char*)lds;
    F.tid = threadIdx.x; F.lane = F.tid & 63; F.wave = __builtin_amdgcn_readfirstlane(F.tid >> 6);
    F.G = gridDim.x; { const int bx = blockIdx.x; F.vcu = (F.G % 8 == 0) ? (bx % 8) * (F.G / 8) + bx / 8 : bx; }
    unsigned char* ws = args.ws;
    bf16* Wt_in = (bf16*)(ws + WS_WIN); bf16* Wt_p = (bf16*)(ws + WS_WP); bf16* Wt_out = (bf16*)(ws + WS_WOUT); bf16* Wt_1 = (bf16*)(ws + WS_W1); bf16* Wt_2 = (bf16*)(ws + WS_W2);
    bf16* PROJ = (bf16*)(ws + WS_PROJ); bf16* HID = (bf16*)(ws + WS_HID); bf16* QB = (bf16*)(ws + WS_Q); bf16* KB = (bf16*)(ws + WS_K); bf16* VB = (bf16*)(ws + WS_V); bf16* MRG = (bf16*)(ws + WS_MRG); bf16* H1 = (bf16*)(ws + WS_H1); bf16* OGLA = (bf16*)(ws + WS_OGLA);
    bf16* U = (bf16*)args.out; bf16* OT = (bf16*)args.out; bf16* Y = (bf16*)((unsigned char*)args.out + 128 * MiB);
    const float* modacc = (const float*)(ws + WS_CTL);
    const int lo = args.ph_lo, hi = args.ph_hi;
#define IN(k) (lo <= (k) && (k) < hi)
    if (F.tid < 4) ((LAS unsigned*)(F.lds + 141024))[F.tid] = 0u;
    __syncthreads();
    const XcdBarrier xbar = xcd_barrier_post((unsigned*)(ws + WS_BAR), (volatile LAS unsigned*)(F.lds + 141024));
#define SEAM(k) do { if (IN(k) && IN((k) + 1)) { if (args.ph_lo < 0) grid.sync(); else xcd_barrier(xbar); } } while (0)

    if (((PH_MASK >> 0) & 1) && IN(0)) { p0_prologue(F, args); } SEAM(0);
    if (((PH_MASK >> 1) & 1) && IN(1)) { modnorm_phase<false>(F, args, args.x, U, args.norm1_g, 0, D); rope_table(F, args); } SEAM(1);
    if (((PH_MASK >> 2) & 1) && IN(2)) {
        pg8::Gemm g{U, Wt_in, T, NPROJ, D}; pg8::StaticOrder S; S.init(T, NPROJ, F.G, (int)blockIdx.x);
        pg8::EpiProj E{QB, PROJ, args.gate_bias, (const float*)(ws + WS_CS), args.qn_g, args.kn_g, (LAS float*)(F.lds + 131072)};
        pg8::gemm_phase<pg8::EpiProj, pg8::StaticOrder, true, true>(F.lds, g, S, E);
    } SEAM(2);
    if (((PH_MASK >> 3) & 1) && IN(3)) {
        for (int it = F.vcu; it < 2048; it += F.G) gla::gla_prep_item(F.lds, PROJ, (float*)(ws + WS_DEC), it >> 10, (it >> 8) & 3, it & 255);
    } SEAM(3);
    if (((PH_MASK >> 4) & 1) && IN(4)) {
#ifndef NO_GLA
        if ((F.vcu & 7) == 4 || F.G < 8) late_transposes(F, args, (F.G < 8) ? F.vcu : (F.vcu >> 3), (F.G < 8) ? F.G : ((F.G + 3) >> 3));
        if ((F.vcu & 7) == 0) for (int u = F.vcu >> 3; u < 32; u += (F.G + 7) >> 3) gla::gla_unit(F.lds, PROJ, (const float*)(ws + WS_DEC), OGLA, u >> 4, (u >> 2) & 3, u & 3);
#endif
#ifndef NO_ATTN
        {
            unsigned* qctr = (unsigned*)(ws + WS_QCTR);
            volatile LAS int* sh = (volatile LAS int*)(F.lds + 140000);
            int q = (int)(__builtin_amdgcn_s_getreg((3 << 11) | 20) & 0x7u), tries = 0;
            for (;;) {
                __syncthreads();
                if (F.tid == 0) { int it = -1;
                    while (tries < 8) { const unsigned v = __hip_atomic_fetch_add(qctr + q * 64, 1u, __ATOMIC_RELAXED, __HIP_MEMORY_SCOPE_AGENT); if (v < 256u) { it = q * 256 + (int)v; break; } q = (q + 1) & 7; ++tries; }
                    sh[0] = it; }
                __syncthreads();
                const int it = sh[0];
                if (it < 0) break;
                const int k = it & 255, bhc = (it >> 8) * 4 + (k & 3), qb = 63 - (k >> 2);
                const int c = bhc & 1, h = (bhc >> 1) & 7, b = bhc >> 4;
                attn_body::attn_unit<8>(b, (h * 2 + c) * 64, (h * 2 + c) * 64, h * 128, (h * 2 + c) * 128, qb, (const attn_body::bf16*)QB, (const attn_body::bf16*)KB, (const attn_body::bf16*)VB, (attn_body::bf16*)OT, (char*)lds);
            }
        }
#endif
    } SEAM(4);
    if (((PH_MASK >> 5) & 1) && IN(5)) { combine_phase(F, args, OT, Y); } SEAM(5);
    if (((PH_MASK >> 6) & 1) && IN(6)) {
        pg8::Gemm g{Y, Wt_p, T, D, D}; pg8::StaticOrder S; S.init(T, D, F.G, (int)blockIdx.x);
        pg8::EpiMerge E{MRG, D, PROJ, PW};
        pg8::gemm_phase<pg8::EpiMerge, pg8::StaticOrder, true, true>(F.lds, g, S, E);
    } SEAM(6);
    if (((PH_MASK >> 7) & 1) && IN(7)) {
        pg8::Gemm g{MRG, Wt_out, T, D, D}; pg8::StaticOrder S; S.init(T, D, F.G, (int)blockIdx.x);
        pg8::EpiRes<false, true> E{args.x, H1, D, modacc, args.b_ada, 2 * D, SEQ};
        pg8::gemm_phase<pg8::EpiRes<false, true>, pg8::StaticOrder, true, true>(F.lds, g, S, E);
    } SEAM(7);
    if (((PH_MASK >> 8) & 1) && IN(8)) { modnorm_phase<true>(F, args, H1, MRG, args.norm2_g, 3 * D, 4 * D); } SEAM(8);
    if (((PH_MASK >> 9) & 1) && IN(9)) {
        pg8::Gemm g{MRG, Wt_1, T, FF, D}; pg8::StaticOrder S; S.init(T, FF, F.G, (int)blockIdx.x);
        pg8::EpiRelu2 E{HID, FF};
        pg8::gemm_phase<pg8::EpiRelu2, pg8::StaticOrder, true, true>(F.lds, g, S, E);
    } SEAM(9);
    if (((PH_MASK >> 10) & 1) && IN(10)) {
        pg8::Gemm g{HID, Wt_2, T, D, FF}; pg8::StaticOrder S; S.init(T, D, F.G, (int)blockIdx.x);
        pg8::EpiRes<true, false> E{H1, args.out, D, modacc, args.b_ada, 5 * D, SEQ};
        pg8::gemm_phase<pg8::EpiRes<true, false>, pg8::StaticOrder, true, true>(F.lds, g, S, E);
    }
#undef IN
#undef SEAM
}

extern "C" void kernel_launch(void* const* d_in, const int* in_sizes, int n_in, void* d_out, int out_size, void* d_ws, size_t ws_size, hipStream_t stream) {
    static int grid = 0;
    if (grid == 0) {
        if (n_in != 23 || out_size != T * D || ws_size < WS_END) { fprintf(stderr, "kernel_launch: unexpected shapes (n_in %d out %d ws %zu)\n", n_in, out_size, ws_size); grid = -1; return; }
        int dev = 0, cus = 0, per_cu = 0;
        if (hipGetDevice(&dev) != hipSuccess || hipDeviceGetAttribute(&cus, hipDeviceAttributeMultiprocessorCount, dev) != hipSuccess) { grid = -1; return; }
        if (hipFuncSetAttribute((const void*)mega_fwd, hipFuncAttributeMaxDynamicSharedMemorySize, LDS_BYTES) != hipSuccess) { fprintf(stderr, "hipFuncSetAttribute failed\n"); grid = -1; return; }
        if (hipOccupancyMaxActiveBlocksPerMultiprocessor(&per_cu, (const void*)mega_fwd, NWAVES * 64, LDS_BYTES) != hipSuccess || per_cu < 1) per_cu = 1;
        (void)hipGetLastError();
        grid = cus * per_cu;
    }
    if (grid < 0) return;
    if (hipMemsetAsync((char*)d_ws + WS_CTL, 0, CTL_ZERO_BYTES, stream) != hipSuccess) { fprintf(stderr, "memset failed\n"); return; }
    Args a{};
    a.x = (const float*)d_in[0]; a.c = (const float*)d_in[1]; a.pos = (const int*)d_in[2]; a.w_ada = (const float*)d_in[3]; a.b_ada = (const float*)d_in[4]; a.norm1_g = (const float*)d_in[5];
    a.w_in = (const float*)d_in[6]; a.qn_g = (const float*)d_in[7]; a.kn_g = (const float*)d_in[8]; a.lq1 = (const float*)d_in[9]; a.lk1 = (const float*)d_in[10]; a.lq2 = (const float*)d_in[11];
    a.lk2 = (const float*)d_in[12]; a.subln_g = (const float*)d_in[13]; a.gate_up = (const float*)d_in[14]; a.gate_bias = (const float*)d_in[15]; a.gout_g = (const float*)d_in[16];
    a.w_pa = (const float*)d_in[17]; a.w_pb = (const float*)d_in[18]; a.w_out = (const float*)d_in[19]; a.norm2_g = (const float*)d_in[20]; a.w1 = (const float*)d_in[21]; a.w2 = (const float*)d_in[22];
    a.out = (float*)d_out; a.ws = (unsigned char*)d_ws; a.ph_lo = 0; a.ph_hi = 11;
    void* kargs[] = {&a};
    const hipError_t e = hipLaunchCooperativeKernel((const void*)mega_fwd, dim3(grid), dim3(NWAVES * 64), kargs, LDS_BYTES, stream);
    if (e != hipSuccess) fprintf(stderr, "cooperative launch failed: %s (grid %d)\n", hipGetErrorString(e), grid);
}
```
